# Optimizing an MI355X kernel written in HIP

```python
import jax, jax.numpy as jnp
from jax import lax
import numpy as np

D_MODEL = 1024
BATCH = 8
SEQ = 4096
DEPTH = 2

CHUNK = 64
BRANCH_W = 512
N_BRANCH = 4
NORM_EPS = 1e-6
SQRT_EPS = 1e-12
HG_HEADS = 4
HG_DK = 128
HG_DV = BRANCH_W // HG_HEADS
GLA_HEADS = 4
GLA_DK = 64
GLA_DV = BRANCH_W // GLA_HEADS
GLA_RANK = 16
GLA_TAU = 16.0
SG_GROUPS = 4
SG_LEN = 128
SG_GW = BRANCH_W // SG_GROUPS
LRU_HEADS = 4
LRU_HD = BRANCH_W // LRU_HEADS
CONV_WIDTH = 4
RG_C = 8.0

IN_SPLITS = (HG_HEADS * HG_DK, HG_HEADS * HG_DK, BRANCH_W, BRANCH_W,
             GLA_HEADS * GLA_DK, GLA_HEADS * GLA_DK, BRANCH_W, BRANCH_W,
             GLA_RANK,
             BRANCH_W, BRANCH_W, BRANCH_W,
             BRANCH_W, BRANCH_W,
             N_BRANCH * D_MODEL)
N_IN = sum(IN_SPLITS)

kernel_name = 'hybrid_hgrn2_gla_sgmlp_rglru_encoder'


def rms_norm(x, w):
    xf = x.astype(jnp.float32)
    y = xf * lax.rsqrt(jnp.mean(xf * xf, axis=-1, keepdims=True) + NORM_EPS)
    return (y * w.astype(jnp.float32)).astype(x.dtype)


def head_rms_norm(o, w):
    y = o * lax.rsqrt(jnp.mean(o * o, axis=-1, keepdims=True) + NORM_EPS) * w.astype(jnp.float32)
    return y.reshape(o.shape[0], o.shape[1], -1)


def chunk_gated_linear_attention(q, k, v, log_decay):
    bsz, seqlen, nh, dk = q.shape
    dv = v.shape[-1]
    n = seqlen // CHUNK

    def to_chunks(t):
        return t.astype(jnp.float32).reshape(bsz, n, CHUNK, nh, t.shape[-1]).transpose(1, 0, 3, 2, 4)

    qc, kc, vc, gc = to_chunks(q), to_chunks(k), to_chunks(v), to_chunks(log_decay)
    bc = jnp.cumsum(gc, axis=3)
    causal = jnp.tril(jnp.ones((CHUNK, CHUNK), dtype=bool))[:, :, None]
    causal_f = causal.astype(jnp.float32)

    def step(state, inp):
        qi, ki, vi, bi = inp
        diff = bi[:, :, :, None, :] - bi[:, :, None, :, :]
        decay = jnp.exp(jnp.where(causal, diff, 0.0)) * causal_f
        scores = jnp.sum(qi[:, :, :, None, :] * decay * ki[:, :, None, :, :], axis=-1)
        o = (jnp.einsum('bhij,bhjv->bhiv', scores, vi)
             + jnp.einsum('bhik,bhkv->bhiv', qi * jnp.exp(bi), state))
        b_last = bi[:, :, -1:, :]
        state = (jnp.exp(b_last[:, :, 0, :, None]) * state
                 + jnp.einsum('bhjk,bhjv->bhkv', ki * jnp.exp(b_last - bi), vi))
        return state, o

    s0 = jnp.zeros((bsz, nh, dk, dv), jnp.float32)
    _, o = lax.scan(step, s0, (qc, kc, vc, bc))
    return o.transpose(1, 0, 3, 2, 4).reshape(bsz, seqlen, nh, dv)


def hgrn2_branch(q, f_logit, inp, gate, lb, norm_w):
    bsz, seqlen, _ = q.shape
    z = f_logit.astype(jnp.float32).reshape(bsz, seqlen, HG_HEADS, HG_DK)
    lbh = lb.reshape(HG_HEADS, HG_DK)
    forget = lbh + (1.0 - lbh) * jax.nn.sigmoid(z)
    log_f = jnp.log(forget)
    key = (1.0 - lbh) * jax.nn.sigmoid(-z)
    qh = q.reshape(bsz, seqlen, HG_HEADS, HG_DK) * (HG_DK ** -0.5)
    vh = inp.reshape(bsz, seqlen, HG_HEADS, HG_DV)
    o = chunk_gated_linear_attention(qh, key, vh, log_f)
    return head_rms_norm(o, norm_w).astype(q.dtype) * jax.nn.silu(gate)


def gla_branch(q, k, v, gate, lowrank, gk_w, gk_b, norm_w):
    bsz, seqlen, _ = q.shape
    gk = (lowrank @ gk_w + gk_b).astype(jnp.float32)
    log_alpha = (jax.nn.log_sigmoid(gk) / GLA_TAU).reshape(bsz, seqlen, GLA_HEADS, GLA_DK)
    qh = q.reshape(bsz, seqlen, GLA_HEADS, GLA_DK) * (GLA_DK ** -0.5)
    kh = k.reshape(bsz, seqlen, GLA_HEADS, GLA_DK)
    vh = v.reshape(bsz, seqlen, GLA_HEADS, GLA_DV)
    o = chunk_gated_linear_attention(qh, kh, vh, log_alpha)
    return head_rms_norm(o, norm_w).astype(q.dtype) * jax.nn.silu(gate)


def spatial_gating_branch(u, v, gate, ln_w, ln_b, w_s, b_s):
    bsz, seqlen, _ = u.shape
    u = jax.nn.gelu(u, approximate=False)
    v = jax.nn.gelu(v, approximate=False)
    vf = v.astype(jnp.float32)
    mu = jnp.mean(vf, axis=-1, keepdims=True)
    var = jnp.mean(jnp.square(vf - mu), axis=-1, keepdims=True)
    vn = ((vf - mu) * lax.rsqrt(var + NORM_EPS) * ln_w.astype(jnp.float32) + ln_b.astype(jnp.float32)).astype(u.dtype)
    vr = vn.reshape(bsz, seqlen // SG_LEN, SG_LEN, SG_GROUPS, SG_GW)
    blk = jnp.arange(SG_LEN) // CHUNK
    mask = (blk[None, :] <= blk[:, None]).astype(w_s.dtype)
    mixed = jnp.einsum('gij,bnjgc->bnigc', w_s * mask, vr) + b_s.T[None, None, :, :, None]
    return u * mixed.reshape(bsz, seqlen, BRANCH_W) * jax.nn.silu(gate)


def rglru_branch(xr, gate, conv_w, conv_b, w_a, b_a, w_x, b_x, lam):
    bsz, seqlen, _ = xr.shape
    xp = jnp.pad(xr, ((0, 0), (CONV_WIDTH - 1, 0), (0, 0)))
    xc = conv_b
    for tap in range(CONV_WIDTH):
        xc = xc + xp[:, tap:tap + seqlen] * conv_w[tap]
    xh = xc.reshape(bsz, seqlen, LRU_HEADS, LRU_HD)
    r = jax.nn.sigmoid(jnp.einsum('bshi,hij->bshj', xh, w_a).reshape(bsz, seqlen, BRANCH_W) + b_a)
    ig = jax.nn.sigmoid(jnp.einsum('bshi,hij->bshj', xh, w_x).reshape(bsz, seqlen, BRANCH_W) + b_x)
    log_a = -RG_C * r.astype(jnp.float32) * jax.nn.softplus(-lam.astype(jnp.float32))
    a = jnp.exp(log_a)
    bterm = jnp.sqrt(jnp.maximum(-jnp.expm1(2.0 * log_a), SQRT_EPS)) * (ig * xc).astype(jnp.float32)

    def combine(left, right):
        a1, b1 = left
        a2, b2 = right
        return a1 * a2, a2 * b1 + b2

    _, h = lax.associative_scan(combine, (a, bterm), axis=1)
    return h.astype(xr.dtype) * jax.nn.silu(gate)


def setup_inputs(seed: int = 0) -> dict:
    key = jax.random.key(seed)
    ks = jax.random.split(key, 24)
    f32 = jnp.float32
    nrm = lambda k, shape, s: jax.random.normal(k, shape, f32) * s
    u_a = jax.random.uniform(ks[20], (DEPTH, BRANCH_W), f32, 0.9, 0.999)
    sig_l = u_a ** (1.0 / RG_C)
    return {
        'x': jax.random.normal(ks[0], (BATCH, SEQ, D_MODEL), f32),
        'norm_w': 1.0 + nrm(ks[1], (DEPTH, D_MODEL), 0.01),
        'w_in': nrm(ks[2], (DEPTH, D_MODEL, N_IN), D_MODEL ** -0.5),
        'hg_lb_logits': nrm(ks[3], (DEPTH, HG_HEADS * HG_DK), 1.0),
        'hg_norm_w': 1.0 + nrm(ks[4], (DEPTH, HG_DV), 0.01),
        'gla_gk_w': nrm(ks[5], (DEPTH, GLA_RANK, GLA_HEADS * GLA_DK), GLA_RANK ** -0.5),
        'gla_gk_b': nrm(ks[6], (DEPTH, GLA_HEADS * GLA_DK), 0.1),
        'gla_norm_w': 1.0 + nrm(ks[7], (DEPTH, GLA_DV), 0.01),
        'sg_ln_w': 1.0 + nrm(ks[8], (DEPTH, BRANCH_W), 0.01),
        'sg_ln_b': nrm(ks[9], (DEPTH, BRANCH_W), 0.01),
        'sg_w': nrm(ks[10], (DEPTH, SG_GROUPS, SG_LEN, SG_LEN), 0.5 * SG_LEN ** -0.5),
        'sg_b': 1.0 + nrm(ks[11], (DEPTH, SG_GROUPS, SG_LEN), 0.1),
        'lru_conv_w': nrm(ks[12], (DEPTH, CONV_WIDTH, BRANCH_W), CONV_WIDTH ** -0.5),
        'lru_conv_b': nrm(ks[13], (DEPTH, BRANCH_W), 0.01),
        'lru_w_a': nrm(ks[14], (DEPTH, LRU_HEADS, LRU_HD, LRU_HD), LRU_HD ** -0.5),
        'lru_b_a': nrm(ks[15], (DEPTH, BRANCH_W), 0.1),
        'lru_w_x': nrm(ks[16], (DEPTH, LRU_HEADS, LRU_HD, LRU_HD), LRU_HD ** -0.5),
        'lru_b_x': nrm(ks[17], (DEPTH, BRANCH_W), 0.1),
        'lru_lambda': jnp.log(sig_l) - jnp.log1p(-sig_l),
        'w_branch': nrm(ks[18], (DEPTH, N_BRANCH, BRANCH_W, D_MODEL), BRANCH_W ** -0.5),
        'w_out': nrm(ks[19], (DEPTH, D_MODEL, D_MODEL), D_MODEL ** -0.5),
        'final_norm_w': 1.0 + nrm(ks[21], (D_MODEL,), 0.01),
    }


def reference(x, norm_w, w_in, hg_lb_logits, hg_norm_w, gla_gk_w, gla_gk_b, gla_norm_w,
              sg_ln_w, sg_ln_b, sg_w, sg_b, lru_conv_w, lru_conv_b, lru_w_a, lru_b_a,
              lru_w_x, lru_b_x, lru_lambda, w_branch, w_out, final_norm_w):
    bsz, seqlen, _ = x.shape
    p = jax.nn.softmax(hg_lb_logits.astype(jnp.float32), axis=0)
    lower_bounds = jnp.cumsum(p, axis=0) - p[0:1]
    offsets = [int(o) for o in np.cumsum(IN_SPLITS)[:-1]]
    h = x
    for l in range(DEPTH):
        z = rms_norm(h, norm_w[l])
        proj = z @ w_in[l]
        (hq, hf, hi, hg, gq, gk, gv, gg, glr, su, sv, sgt, rx, rg, mg) = jnp.split(proj, offsets, axis=-1)
        y_a = hgrn2_branch(hq, hf, hi, hg, lower_bounds[l], hg_norm_w[l])
        y_b = gla_branch(gq, gk, gv, gg, glr, gla_gk_w[l], gla_gk_b[l], gla_norm_w[l])
        y_c = spatial_gating_branch(su, sv, sgt, sg_ln_w[l], sg_ln_b[l], sg_w[l], sg_b[l])
        y_d = rglru_branch(rx, rg, lru_conv_w[l], lru_conv_b[l], lru_w_a[l], lru_b_a[l],
                           lru_w_x[l], lru_b_x[l], lru_lambda[l])
        gates = jax.nn.sigmoid(mg.reshape(bsz, seqlen, N_BRANCH, D_MODEL))
        branches = (y_a, y_b, y_c, y_d)
        merged = gates[:, :, 0] * (branches[0] @ w_branch[l, 0])
        for bi in range(1, N_BRANCH):
            merged = merged + gates[:, :, bi] * (branches[bi] @ w_branch[l, bi])
        h = h + merged @ w_out[l]
    return rms_norm(h, final_norm_w)
```

```cpp
#include <hip/hip_runtime.h>
#include <hip/hip_cooperative_groups.h>
#include <cstdio>
#include <cstdint>
namespace cg = cooperative_groups;

#define LAS __attribute__((address_space(3)))
typedef unsigned short bf16_t;
typedef short bf16x8 __attribute__((ext_vector_type(8)));
typedef float f32x4 __attribute__((ext_vector_type(4)));
typedef unsigned u32x4 __attribute__((ext_vector_type(4)));
typedef unsigned u32x2 __attribute__((ext_vector_type(2)));

constexpr int DM = 1024, SEQ = 4096, NTOK = 32768, TH = 16384  , NIN = 10256;
constexpr int NP = 7168, NG1 = 6400;
constexpr int C_HG = 0, C_GG = 512, C_SGT = 1024, C_RG = 1536;
constexpr int C_HQ = 2048, C_HF = 2560, C_HI = 3072, C_GQ = 3584, C_GK = 3840, C_GV = 4096, C_GKL = 4608, C_SU = 4864, C_SV = 5376, C_RX = 5888;
constexpr int C_PA = 6400  , C_Z = 6656  ;
constexpr int C_MERGED = 2048;
constexpr int LDS_BYTES = 147456;
constexpr float NORM_EPS = 1e-6f;

constexpr size_t WS_PROJ = 0;
constexpr size_t WS_GATES = WS_PROJ + (size_t)TH * NP * 2;
constexpr size_t WS_W1T = WS_GATES + (size_t)TH * 4096 * 2;
constexpr size_t WS_WMG = WS_W1T + (size_t)2 * NG1 * 1024 * 2;
constexpr size_t WS_WB = WS_WMG + (size_t)2 * 4096 * 1024 * 2;
constexpr size_t WS_WO = WS_WB + (size_t)2 * 1024 * 2048 * 2;
constexpr size_t WS_HB = WS_WO + (size_t)2 * 1024 * 1024 * 2;
constexpr size_t WS_PART = WS_HB + (size_t)TH * 1024 * 2;
constexpr size_t WS_RSTD = WS_PART + (size_t)TH * 1024 * 4;
constexpr size_t WS_ESCA = WS_RSTD + (size_t)TH * 4;
constexpr size_t WS_ESCB = WS_ESCA + (size_t)16 * 64 * 3 * 128 * 4;
constexpr size_t WS_CAR = WS_ESCB + (size_t)16 * 64 * 3 * 64 * 4;
constexpr size_t WS_HIN = WS_CAR + (size_t)4 * 64 * 512 * 2 * 4;
constexpr size_t WS_CTL = WS_HIN + (size_t)4 * 64 * 512 * 4;
constexpr size_t WS_BAR = WS_CTL + 4096;
constexpr size_t WS_END = WS_BAR + 16384;

struct Params { const float* in[22]; float* out; unsigned char* ws; };

__device__ __forceinline__ float bf2f(bf16_t b) { return __uint_as_float(((unsigned)b) << 16); }
typedef __bf16 bf16n2 __attribute__((ext_vector_type(2)));
typedef float f32x2 __attribute__((ext_vector_type(2)));
__device__ __forceinline__ unsigned cvt_pk_bf16(float lo, float hi) { const f32x2 v = {lo, hi}; const bf16n2 b = __builtin_convertvector(v, bf16n2); unsigned r; __builtin_memcpy(&r, &b, 4); return r; }
__device__ __forceinline__ bf16_t f2bf(float f) { return (bf16_t)(cvt_pk_bf16(f, 0.f) & 0xffffu); }
__device__ __forceinline__ float sigm(float x) { return __builtin_amdgcn_rcpf(1.0f + __expf(-x)); }
__device__ __forceinline__ float silu(float x) { return x * sigm(x); }
__device__ __forceinline__ float gelu_erf(float v) {
    const float av = fabsf(v), t = __builtin_amdgcn_rcpf(av * 0.2316418882f + 1.0f);
    float q = t * 0.5307027145f + (-0.7265760135f); q = q * t + 0.7107068705f; q = q * t + (-0.142248368f); q = q * t + 0.127414796f; q = q * t;
    const float e = __builtin_amdgcn_exp2f((v * v) * (-0.72134752044f));
    const float m = v * (q * e);
    return v < 0.f ? m : v - m;
}
__device__ __forceinline__ float wave_sum(float v) {
#pragma unroll
    for (int o = 32; o >= 1; o >>= 1) v += __shfl_xor(v, o);
    return v;
}
__device__ __forceinline__ int opaque_tid() { int t = threadIdx.x; asm volatile("" : "+v"(t)); return t; }
__device__ __forceinline__ int opaque_s(int v) { asm volatile("" : "+s"(v)); return v; }

namespace gm {
constexpr int BM = 256, BK = 64, HALF = 128, HTB = HALF * BK * 2, STAGE_BYTES = 8 * HTB, NXCD = 8, WGM = 8;
__device__ __forceinline__ int lds_byte(int r, int c) { const int st = (r >> 4) * 2 + (c >> 5), rr = r & 15, cc = c & 31, ob = rr * 64 + cc * 2; return st * 1024 + (ob ^ (((ob >> 9) & 1) << 5)); }
__device__ __forceinline__ void stage_rc(int b, int& R, int& C) { const int st = b / 1024, sb = b % 1024, swz = sb ^ (((sb >> 9) & 1) << 5); R = (st >> 1) * 16 + swz / 64; C = (st & 1) * 32 + (swz % 64) / 2; }
__device__ __forceinline__ int perm32(int rho) { const int n = rho >> 4, i = rho & 15; return 8 * (i >> 2) + 4 * n + (i & 3); }

struct Unit { const char* A; const char* B; int pm, pn, aux; };

__device__ __forceinline__ void tile_map(int wgid, const int nM, const int nN, int& pm, int& pn) {
    const int nwg = nM * nN;
    { const int q = nwg / NXCD, r = nwg % NXCD, xcd = wgid % NXCD, off = wgid / NXCD; wgid = (xcd < r ? xcd * (q + 1) : r * (q + 1) + (xcd - r) * q) + off; }
    const int nig = WGM * nN, gid = wgid / nig, fm = gid * WGM, gsz = (nM - fm) < WGM ? (nM - fm) : WGM;
    pm = fm + ((wgid % nig) % gsz); pn = (wgid % nig) / gsz;
}
struct StaticOrder {
    const char* Abase; const char* Bbase; size_t tA, tB; int nM, nN, lim, G, c;
    __device__ void init(const void* A, const void* B, int lda, int ldb, int M, int N, int G_, int c_, int lim_ = -1) {
        Abase = (const char*)A; Bbase = (const char*)B; tA = (size_t)BM * lda * 2; tB = (size_t)BM * ldb * 2; nM = M / BM; nN = N / BM; lim = lim_ < 0 ? nM * nN : lim_; G = G_; c = c_; }
    __device__ bool next(int i, Unit& u) const {
        const long L = (long)i * G + c; if (L >= lim) return false;
        tile_map((int)L, nM, nN, u.pm, u.pn); u.aux = 0;
        u.A = Abase + (size_t)u.pm * tA; u.B = Bbase + (size_t)u.pn * tB; return true;
    }
};
struct InProjOrder {
    const char* Abase; const char* B0; const char* B1; size_t tA, tB; int nx, G, c;
    __device__ bool next(int i, Unit& u) const {
        const long L = (long)i * G + c;
        if (L < 1600) { tile_map((int)L, 64, 25, u.pm, u.pn); u.aux = 0; u.B = B0 + (size_t)u.pn * tB; }
        else if (L < 1600 + nx) { tile_map(1024 - nx + (int)(L - 1600), 64, 16, u.pm, u.pn); u.aux = 1; u.B = B1 + (size_t)u.pn * tB; }
        else return false;
        u.A = Abase + (size_t)u.pm * tA; return true;
    }
};
struct BranchOrder {
    const char* Abase; const char* Bbase; size_t tA, tB; int G, c;
    __device__ bool next(int i, Unit& u) const {
        const int tt = c + (i >> 2) * G; if (tt >= 256) return false;
        const int b = i & 3; u.pm = tt >> 2; u.pn = tt & 3; u.aux = b;
        u.A = Abase + (size_t)u.pm * tA + (size_t)b * 1024; u.B = Bbase + (size_t)u.pn * tB + (size_t)b * 1024; return true;
    }
};

template <int ACT> struct EpiRowScaleBf16 {
    static constexpr bool PERM = true;
    bf16_t* O; int ldc; const float* rstd;
    __device__ __forceinline__ void operator()(const f32x4 (&acc)[2][2][4][2], const Unit& u, int wr, int wc, int fr, int fq) const {
        const int row0 = u.pm * BM + wr * 64 + fr, col0 = u.pn * BM + wc * 32 + 8 * fq;
        float rs[2][4];
#pragma unroll
        for (int ai = 0; ai < 2; ++ai)
#pragma unroll
            for (int m = 0; m < 4; ++m) rs[ai][m] = rstd[row0 + ai * HALF + m * 16];
#pragma unroll
        for (int ai = 0; ai < 2; ++ai)
#pragma unroll
            for (int m = 0; m < 4; ++m) { const int row = row0 + ai * HALF + m * 16; bf16_t* rowp = O + (size_t)row * ldc + col0;
#pragma unroll
                for (int bj = 0; bj < 2; ++bj) { f32x4 v0 = acc[ai][bj][m][0] * rs[ai][m], v1 = acc[ai][bj][m][1] * rs[ai][m];
                    if (ACT == 1) {
#pragma unroll
                        for (int j = 0; j < 4; ++j) { v0[j] = sigm(v0[j]); v1[j] = sigm(v1[j]); } }
                    u32x4 w; w.x = cvt_pk_bf16(v0[0], v0[1]); w.y = cvt_pk_bf16(v0[2], v0[3]); w.z = cvt_pk_bf16(v1[0], v1[1]); w.w = cvt_pk_bf16(v1[2], v1[3]);
                    *(u32x4*)(rowp + bj * HALF) = w; } }
    }
};
struct EpiInProj {
    static constexpr bool PERM = true;
    EpiRowScaleBf16<0> e0; EpiRowScaleBf16<1> e1;
    __device__ __forceinline__ void operator()(const f32x4 (&acc)[2][2][4][2], const Unit& u, int wr, int wc, int fr, int fq) const {
        if (u.aux) e1(acc, u, wr, wc, fr, fq); else e0(acc, u, wr, wc, fr, fq); }
};
struct EpiBranch {
    static constexpr bool PERM = true;
    const bf16_t* gates; bf16_t* part; bf16_t* merged; int ldm;
    __device__ __forceinline__ void operator()(const f32x4 (&acc)[2][2][4][2], const Unit& u, int wr, int wc, int fr, int fq) const {
        const int row0 = u.pm * BM + wr * 64 + fr, col0 = u.pn * BM + wc * 32 + 8 * fq; const int b = u.aux;
#pragma unroll
        for (int ai = 0; ai < 2; ++ai) {
            u32x4 g[4][2], pv[4][2];
#pragma unroll
            for (int m = 0; m < 4; ++m) { const int row = row0 + ai * HALF + m * 16;
#pragma unroll
                for (int bj = 0; bj < 2; ++bj) { g[m][bj] = *(const u32x4*)(gates + (size_t)row * 4096 + b * 1024 + col0 + bj * HALF);
                    if (b > 0) pv[m][bj] = *(const u32x4*)(part + (size_t)row * 1024 + col0 + bj * HALF); } }
#pragma unroll
            for (int m = 0; m < 4; ++m) { const int row = row0 + ai * HALF + m * 16;
#pragma unroll
                for (int bj = 0; bj < 2; ++bj) { const u32x4 gg = g[m][bj];
                    f32x4 g0, g1;
                    g0[0] = __uint_as_float(gg.x << 16); g0[1] = __uint_as_float(gg.x & 0xffff0000u); g0[2] = __uint_as_float(gg.y << 16); g0[3] = __uint_as_float(gg.y & 0xffff0000u);
                    g1[0] = __uint_as_float(gg.z << 16); g1[1] = __uint_as_float(gg.z & 0xffff0000u); g1[2] = __uint_as_float(gg.w << 16); g1[3] = __uint_as_float(gg.w & 0xffff0000u);
                    f32x4 v0 = acc[ai][bj][m][0] * g0, v1 = acc[ai][bj][m][1] * g1;
                    if (b > 0) { const u32x4 pp = pv[m][bj];
                        v0[0] += __uint_as_float(pp.x << 16); v0[1] += __uint_as_float(pp.x & 0xffff0000u); v0[2] += __uint_as_float(pp.y << 16); v0[3] += __uint_as_float(pp.y & 0xffff0000u);
                        v1[0] += __uint_as_float(pp.z << 16); v1[1] += __uint_as_float(pp.z & 0xffff0000u); v1[2] += __uint_as_float(pp.w << 16); v1[3] += __uint_as_float(pp.w & 0xffff0000u); }
                    u32x4 w; w.x = cvt_pk_bf16(v0[0], v0[1]); w.y = cvt_pk_bf16(v0[2], v0[3]); w.z = cvt_pk_bf16(v1[0], v1[1]); w.w = cvt_pk_bf16(v1[2], v1[3]);
                    if (b < 3) *(u32x4*)(part + (size_t)row * 1024 + col0 + bj * HALF) = w;
                    else *(u32x4*)(merged + (size_t)row * ldm + col0 + bj * HALF) = w; } }
            asm volatile("" ::: "memory"); }
    }
};
struct EpiResidual {
    static constexpr bool PERM = false;
    const float* src; float* dst;
    __device__ __forceinline__ void operator()(const f32x4 (&acc)[2][2][4][2], const Unit& u, int wr, int wc, int fr, int fq) const {
        const int row0 = u.pm * BM + wr * 64 + fr, col0 = u.pn * BM + wc * 32 + 4 * fq;
#pragma unroll
        for (int ai = 0; ai < 2; ++ai) {
            f32x4 sv[4][2][2];
#pragma unroll
            for (int m = 0; m < 4; ++m) { const size_t off = (size_t)(row0 + ai * HALF + m * 16) * 1024 + col0;
#pragma unroll
                for (int bj = 0; bj < 2; ++bj)
#pragma unroll
                    for (int n = 0; n < 2; ++n) sv[m][bj][n] = *(const f32x4*)(src + off + bj * HALF + n * 16); }
#pragma unroll
            for (int m = 0; m < 4; ++m) { const size_t off = (size_t)(row0 + ai * HALF + m * 16) * 1024 + col0;
#pragma unroll
                for (int bj = 0; bj < 2; ++bj)
#pragma unroll
                    for (int n = 0; n < 2; ++n) *(f32x4*)(dst + off + bj * HALF + n * 16) = sv[m][bj][n] + acc[ai][bj][m][n]; }
            asm volatile("" ::: "memory"); }
    }
};

template <class Epi, class Sched>
__device__ __forceinline__ void gemm_phase(LAS unsigned char* lds, const Sched& S, const Epi& E, const int K, const int lda, const int ldb) {
    const int tid = opaque_tid(), wid = __builtin_amdgcn_readfirstlane(tid >> 6), lane = tid & 63, wr = wid >> 2, wc = wid & 3, fr = lane & 15, fq = lane >> 4;
    const int nt = K / BK;
    unsigned voffA[2], voffB[2];
#pragma unroll
    for (int i = 0; i < 2; ++i) { int R, C; stage_rc(tid * 16 + i * 8192, R, C); const int Rb = Epi::PERM ? ((R & ~31) + perm32(R & 31)) : R;
        voffA[i] = (unsigned)(R * lda + C) * 2u; voffB[i] = (unsigned)(Rb * ldb + C) * 2u; }
    const size_t kstep = (size_t)(BK * 2);
    const size_t hstepA = (size_t)HALF * lda * 2, hstepB = (size_t)HALF * ldb * 2;
    const unsigned ldsw = (unsigned)wid * 1024u;
    const int aoff = lds_byte(wr * 64 + fr, fq * 8), boff = lds_byte(wc * 32 + fr, fq * 8);
#define PG8_SA(b, h) (((b) * 2 + (h)) * HTB)
#define PG8_SB(b, h) ((4 + (b) * 2 + (h)) * HTB)
#define PG8_STAGE(bufoff, gbase, voff) do { _Pragma("unroll") for (int _i = 0; _i < 2; ++_i) \
        __builtin_amdgcn_global_load_lds((const unsigned*)((const char*)(gbase) + (voff)[_i]), (LAS unsigned*)(lds + (bufoff) + ldsw + _i * 8192), 16, 0, 0); } while (0)
#define PG8_LDA(dst, b, h) do { _Pragma("unroll") for (int m = 0; m < 4; ++m) _Pragma("unroll") for (int k = 0; k < 2; ++k) dst[m][k] = *(const LAS bf16x8*)(lds + PG8_SA(b, h) + aoff + m * 2048 + k * 1024); } while (0)
#define PG8_LDB(dst, b, h) do { _Pragma("unroll") for (int n = 0; n < 2; ++n) _Pragma("unroll") for (int k = 0; k < 2; ++k) dst[n][k] = *(const LAS bf16x8*)(lds + PG8_SB(b, h) + boff + n * 2048 + k * 1024); } while (0)
#define PG8_MMA(ai, bj, At, Bt) do { __builtin_amdgcn_s_setprio(1); _Pragma("unroll") for (int m = 0; m < 4; ++m) _Pragma("unroll") for (int n = 0; n < 2; ++n) _Pragma("unroll") for (int k = 0; k < 2; ++k) \
        acc[ai][bj][m][n] = __builtin_amdgcn_mfma_f32_16x16x32_bf16(Bt[n][k], At[m][k], acc[ai][bj][m][n], 0, 0, 0); __builtin_amdgcn_s_setprio(0); } while (0)
#define PG8_WAIT_V(n) asm volatile("s_waitcnt vmcnt(" #n ")" ::: "memory")
#define PG8_WAIT_L(n) asm volatile("s_waitcnt lgkmcnt(" #n ")" ::: "memory")
#define PG8_BAR __builtin_amdgcn_s_barrier()
#define PG8_SCHED __builtin_amdgcn_sched_barrier(0)
    Unit cur, nxt; int ui = 0;
    if (!S.next(0, cur)) return;
    f32x4 acc[2][2][4][2];
#pragma unroll
    for (int a = 0; a < 2; ++a)
#pragma unroll
        for (int b = 0; b < 2; ++b)
#pragma unroll
            for (int m = 0; m < 4; ++m)
#pragma unroll
                for (int n = 0; n < 2; ++n) acc[a][b][m][n] = (f32x4){0.f, 0.f, 0.f, 0.f};
    bf16x8 At[4][2], B0[2][2], B1[2][2];
    const char* cA = cur.A; const char* cB = cur.B;
    PG8_STAGE(PG8_SB(0, 0), cB, voffB); PG8_STAGE(PG8_SA(0, 0), cA, voffA); PG8_STAGE(PG8_SB(0, 1), cB + hstepB, voffB); PG8_STAGE(PG8_SA(0, 1), cA + hstepA, voffA);
    if (wr == 1) PG8_BAR;
    PG8_WAIT_V(4); PG8_BAR;
    PG8_STAGE(PG8_SB(1, 0), cB + kstep, voffB); PG8_STAGE(PG8_SA(1, 0), cA + kstep, voffA); PG8_STAGE(PG8_SB(1, 1), cB + hstepB + kstep, voffB);
    PG8_WAIT_V(6); PG8_BAR;
    for (;;) {
        const bool has_next = S.next(ui + 1, nxt);
        const char* nA = has_next ? nxt.A : cA; const char* nB = has_next ? nxt.B : cB;
        for (int t = 0; t < nt; t += 2) {
            const bool last = (t == nt - 2);
            const char* a1 = cA + (size_t)(t + 1) * kstep;
            const char* a2 = last ? nA : cA + (size_t)(t + 2) * kstep; const char* b2 = last ? nB : cB + (size_t)(t + 2) * kstep;
            const char* a3 = a2 + kstep; const char* b3 = b2 + kstep;
            PG8_LDB(B0, 0, 0); PG8_SCHED; PG8_LDA(At, 0, 0); PG8_STAGE(PG8_SA(1, 1), a1 + hstepA, voffA);
            PG8_WAIT_L(8); PG8_BAR; PG8_WAIT_L(0); PG8_MMA(0, 0, At, B0); PG8_BAR; PG8_SCHED;
            PG8_LDB(B1, 0, 1); PG8_STAGE(PG8_SB(0, 0), b2, voffB);
            PG8_BAR; PG8_WAIT_L(0); PG8_MMA(0, 1, At, B1); PG8_BAR;
            PG8_LDA(At, 0, 1); PG8_STAGE(PG8_SA(0, 0), a2, voffA);
            PG8_BAR; PG8_WAIT_L(0); PG8_MMA(1, 0, At, B0); PG8_BAR; PG8_SCHED;
            PG8_STAGE(PG8_SB(0, 1), b2 + hstepB, voffB);
            PG8_WAIT_V(6); PG8_BAR; PG8_MMA(1, 1, At, B1); PG8_BAR;
            PG8_LDB(B0, 1, 0); PG8_SCHED; PG8_LDA(At, 1, 0); PG8_STAGE(PG8_SA(0, 1), a2 + hstepA, voffA);
            PG8_WAIT_L(8); PG8_BAR; PG8_WAIT_L(0); PG8_MMA(0, 0, At, B0); PG8_BAR; PG8_SCHED;
            PG8_LDB(B1, 1, 1); PG8_STAGE(PG8_SB(1, 0), b3, voffB);
            PG8_BAR; PG8_WAIT_L(0); PG8_MMA(0, 1, At, B1); PG8_BAR;
            PG8_LDA(At, 1, 1); PG8_STAGE(PG8_SA(1, 0), a3, voffA);
            PG8_BAR; PG8_WAIT_L(0); PG8_MMA(1, 0, At, B0); PG8_BAR; PG8_SCHED;
            PG8_STAGE(PG8_SB(1, 1), b3 + hstepB, voffB);
            PG8_WAIT_V(6); PG8_BAR; PG8_MMA(1, 1, At, B1); PG8_BAR;
        }
        E(acc, cur, wr, wc, fr, fq);
        if (!has_next) break;
#pragma unroll
        for (int a = 0; a < 2; ++a)
#pragma unroll
            for (int b = 0; b < 2; ++b)
#pragma unroll
                for (int m = 0; m < 4; ++m)
#pragma unroll
                    for (int n = 0; n < 2; ++n) acc[a][b][m][n] = (f32x4){0.f, 0.f, 0.f, 0.f};
        cur = nxt; cA = nA; cB = nB; ++ui;
    }
    PG8_WAIT_V(0);
    if (wr == 0) PG8_BAR;
    PG8_BAR;
#undef PG8_SA
#undef PG8_SB
#undef PG8_STAGE
#undef PG8_LDA
#undef PG8_LDB
#undef PG8_MMA
#undef PG8_WAIT_V
#undef PG8_WAIT_L
#undef PG8_BAR
#undef PG8_SCHED
}
}

#define LDS_BAR() do { asm volatile("s_waitcnt lgkmcnt(0)" ::: "memory"); __builtin_amdgcn_s_barrier(); asm volatile("" ::: "memory"); } while (0)
#define MFMA16(a, b, c) __builtin_amdgcn_mfma_f32_16x16x32_bf16((a), (b), (c), 0, 0, 0)

__device__ __forceinline__ int w1_src_col(int n0) {
    if (n0 < 512) return 1536 + n0;
    if (n0 < 1024) return 3072 + (n0 - 512);
    if (n0 < 1536) return 4624 + (n0 - 1024);
    if (n0 < 2048) return 5648 + (n0 - 1536);
    if (n0 < 2560) return 0 + (n0 - 2048);
    if (n0 < 3072) return 512 + (n0 - 2560);
    if (n0 < 3584) return 1024 + (n0 - 3072);
    if (n0 < 3840) return 2048 + (n0 - 3584);
    if (n0 < 4096) return 2304 + (n0 - 3840);
    if (n0 < 4608) return 2560 + (n0 - 4096);
    if (n0 < 4864) return -1;
    if (n0 < 5376) return 3600 + (n0 - 4864);
    if (n0 < 5888) return 4112 + (n0 - 5376);
    return 5136 + (n0 - 5888);
}
struct ProTile { const float* src; const float* scale; const float* gw; bf16_t* dst; int ldsrc, scol, n0, k0, ldd; };
__device__ __forceinline__ ProTile pro_tile(const Params& p, const int idx) {
    const float* norm_w = p.in[1]; const float* w_in = p.in[2]; const float* gk_w = p.in[5]; const float* w_branch = p.in[19]; const float* w_out = p.in[20];
    ProTile t; t.scale = nullptr; t.gw = nullptr;
    const int l = idx / 3392; int r = idx % 3392;
    if (r < 1600) { t.n0 = (r >> 4) * 64; t.k0 = (r & 15) * 64; t.src = w_in + (size_t)l * 1024 * NIN; t.ldsrc = NIN; t.scol = w1_src_col(t.n0); t.scale = norm_w + l * 1024;
        if (t.scol < 0) t.gw = gk_w + (size_t)l * 16 * 256 + (t.n0 - C_GKL);
        t.dst = (bf16_t*)(p.ws + WS_W1T) + (size_t)l * NG1 * 1024; t.ldd = 1024; }
    else if (r < 2624) { r -= 1600; t.n0 = (r >> 4) * 64; t.k0 = (r & 15) * 64; t.src = w_in + (size_t)l * 1024 * NIN; t.ldsrc = NIN; t.scol = 6160 + t.n0; t.scale = norm_w + l * 1024;
        t.dst = (bf16_t*)(p.ws + WS_WMG) + (size_t)l * 4096 * 1024; t.ldd = 1024; }
    else if (r < 3136) { r -= 2624; const int b = r >> 7; const int r2 = r & 127; t.n0 = (r2 >> 3) * 64; t.k0 = (r2 & 7) * 64; t.src = w_branch + (size_t)(l * 4 + b) * 512 * 1024; t.ldsrc = 1024; t.scol = t.n0;
        t.dst = (bf16_t*)(p.ws + WS_WB) + (size_t)l * 1024 * 2048 + b * 512; t.ldd = 2048; }
    else { r -= 3136; t.n0 = (r >> 4) * 64; t.k0 = (r & 15) * 64; t.src = w_out + (size_t)l * 1024 * 1024; t.ldsrc = 1024; t.scol = t.n0;
        t.dst = (bf16_t*)(p.ws + WS_WO) + (size_t)l * 1024 * 1024; t.ldd = 1024; }
    return t;
}
__device__ void prologue_phase(const Params& p, LAS unsigned char* lds, const int G) {
    constexpr int NT = 2 * 3392, GRP = 4;
    const int tid = opaque_tid();
    const int n = tid & 63, kq = tid >> 6, nn = tid >> 3, k8 = tid & 7;
    for (int base = blockIdx.x * GRP; base < NT; base += G * GRP) {
#pragma unroll
        for (int gi = 0; gi < GRP; ++gi) { if (base + gi >= NT) break; const int idx = (int)(((long)(base + gi) * 61) % NT);
            const ProTile t = pro_tile(p, idx); LAS float* tile = (LAS float*)(lds + gi * 16896);
#pragma unroll
            for (int e = 0; e < 8; ++e) { const int k = kq * 8 + e; float v;
                if (!t.gw) v = t.src[(size_t)(t.k0 + k) * t.ldsrc + t.scol + n];
                else { v = 0.f; const float* lr = t.src + (size_t)(t.k0 + k) * NIN + 3584;
                    for (int rr = 0; rr < 16; ++rr) v += lr[rr] * t.gw[rr * 256 + n]; }
                if (t.scale) v *= t.scale[t.k0 + k];
                tile[k * 65 + n] = v; } }
        LDS_BAR();
#pragma unroll
        for (int gi = 0; gi < GRP; ++gi) { if (base + gi >= NT) break; const int idx = (int)(((long)(base + gi) * 61) % NT);
            const ProTile t = pro_tile(p, idx); LAS float* tile = (LAS float*)(lds + gi * 16896); float v[8];
#pragma unroll
            for (int e = 0; e < 8; ++e) v[e] = tile[(k8 * 8 + e) * 65 + nn];
            u32x4 w; w.x = cvt_pk_bf16(v[0], v[1]); w.y = cvt_pk_bf16(v[2], v[3]); w.z = cvt_pk_bf16(v[4], v[5]); w.w = cvt_pk_bf16(v[6], v[7]);
            *(u32x4*)(t.dst + (size_t)(t.n0 + nn) * t.ldd + t.k0 + k8 * 8) = w; }
        LDS_BAR();
    }
}

__device__ void pre_phase(const float* hsrc, bf16_t* hb, float* rstd, const int G) {
    const int tid = opaque_tid(); const int lane = tid & 63, wv = tid >> 6;
    for (int rr = blockIdx.x * 32 + wv * 4; rr < TH; rr += G * 32)
    for (int r = rr; r < rr + 4; ++r) {
        const float* row = hsrc + (size_t)r * 1024; f32x4 v[4]; float ss = 0.f;
#pragma unroll
        for (int e = 0; e < 4; ++e) { v[e] = *(const f32x4*)(row + e * 256 + lane * 4); ss += v[e][0] * v[e][0] + v[e][1] * v[e][1] + v[e][2] * v[e][2] + v[e][3] * v[e][3]; }
        ss = wave_sum(ss);
        if (lane == 0) rstd[r] = rsqrtf(ss * (1.0f / 1024.0f) + NORM_EPS);
#pragma unroll
        for (int e = 0; e < 4; ++e) { u32x2 w; w.x = cvt_pk_bf16(v[e][0], v[e][1]); w.y = cvt_pk_bf16(v[e][2], v[e][3]); *(u32x2*)(hb + (size_t)r * 1024 + e * 256 + lane * 4) = w; }
    }
}
__device__ void final_phase(float* out, const float* w, const int G) {
    const int tid = opaque_tid(); const int lane = tid & 63, gw = blockIdx.x * 8 + (tid >> 6), nw = G * 8;
    f32x4 wv[4];
#pragma unroll
    for (int e = 0; e < 4; ++e) wv[e] = *(const f32x4*)(w + e * 256 + lane * 4);
    for (int r = gw; r < NTOK; r += nw) {
        float* row = out + (size_t)r * 1024; f32x4 v[4]; float ss = 0.f;
#pragma unroll
        for (int e = 0; e < 4; ++e) { v[e] = *(const f32x4*)(row + e * 256 + lane * 4); ss += v[e][0] * v[e][0] + v[e][1] * v[e][1] + v[e][2] * v[e][2] + v[e][3] * v[e][3]; }
        ss = wave_sum(ss);
        const float rs = rsqrtf(ss * (1.0f / 1024.0f) + NORM_EPS);
#pragma unroll
        for (int e = 0; e < 4; ++e) *(f32x4*)(row + e * 256 + lane * 4) = v[e] * rs * wv[e];
    }
}

constexpr int CA_QT = 0, CA_KT = 17408, CA_CS = 34816;
constexpr int PREP_NCH = 4;
template <int DK, bool GLA>
__device__ void prep_attn(LAS unsigned char* lds, bf16_t* proj, const int bl, const int h, const int c, const int layer, const float* lb_logits, const float* gk_b, float* esc) {
    constexpr int NPQ = 512 / DK, PL = 64 / NPQ, QS = (DK + 8) * 2, KS = DK / 32;
    const int tid = opaque_tid(), lane = tid & 63, w = __builtin_amdgcn_readfirstlane(tid >> 6), fr = lane & 15, fq = lane >> 4;
    const int k = tid % DK, pq = tid / DK;
    const int vj = tid & 127, vq = tid >> 7;
    const int cq = GLA ? (C_GQ + h * 64) : (C_HQ + h * 128), cz = GLA ? (C_GKL + h * 64) : (C_HF + h * 128), ck = C_GK + h * 64;
    const int cv = (GLA ? C_GV : C_HI) + h * 128, cp = (GLA ? C_GKL : C_PA) + h * 64, ckt = GLA ? ck : cz;
    const float scale = GLA ? 0.125f : 0.08838834764831845f;
    float lb = 0.f, gbias = 0.f;
    if (GLA) gbias = gk_b[layer * 256 + h * 64 + k];
    else if (layer == 1) lb = sigm(lb_logits[512 + h * 128 + k] - lb_logits[h * 128 + k]);
    const float oml = 1.0f - lb;
    LAS float* cs = (LAS float*)(lds + CA_CS);
    bf16_t* tbase = proj + ((size_t)bl * SEQ + (size_t)c * 64) * NP;
    const unsigned eoff = (unsigned)(pq * PL) * NP + k, voff = (unsigned)(vq * 16) * NP + vj;
    bf16_t rq[PL], rz[PL], rk[PL], rv[16];
#pragma unroll
    for (int e = 0; e < PL; ++e) { const bf16_t* rp = tbase + e * NP; rq[e] = (rp + cq)[eoff]; rz[e] = (rp + cz)[eoff]; rk[e] = GLA ? (rp + ck)[eoff] : (bf16_t)0; }
#pragma unroll
    for (int e = 0; e < 16; ++e) rv[e] = (tbase + e * NP + cv)[voff];
  for (int cc = 0; cc < PREP_NCH; ++cc) {
    bf16_t* t0 = tbase + (size_t)cc * 64 * NP;
    float bl_[PL], kk[PL], qq[PL]; float run = 0.f;
#pragma unroll
    for (int e = 0; e < PL; ++e) { const float z = bf2f(rz[e]); float lf, key;
        if (GLA) { const float x = z + gbias; lf = (fminf(x, 0.f) - __logf(1.0f + __expf(-fabsf(x)))) * 0.0625f; key = bf2f(rk[e]); }
        else { const float sg = sigm(fmaxf(z, -80.f)); lf = __logf(lb + oml * sg); key = oml * (1.0f - sg); }
        run += lf; bl_[e] = run; kk[e] = key; qq[e] = bf2f(rq[e]) * scale; }
    cs[pq * DK + k] = run;
    u32x4 w0, w1; w0.x = rv[0] | ((unsigned)rv[1] << 16); w0.y = rv[2] | ((unsigned)rv[3] << 16); w0.z = rv[4] | ((unsigned)rv[5] << 16); w0.w = rv[6] | ((unsigned)rv[7] << 16);
    w1.x = rv[8] | ((unsigned)rv[9] << 16); w1.y = rv[10] | ((unsigned)rv[11] << 16); w1.z = rv[12] | ((unsigned)rv[13] << 16); w1.w = rv[14] | ((unsigned)rv[15] << 16);
    LDS_BAR();
    if (cc + 1 < PREP_NCH) { const bf16_t* t1 = t0 + (size_t)64 * NP;
#pragma unroll
        for (int e = 0; e < PL; ++e) { const bf16_t* rp = t1 + e * NP; rq[e] = (rp + cq)[eoff]; rz[e] = (rp + cz)[eoff]; rk[e] = GLA ? (rp + ck)[eoff] : (bf16_t)0; }
#pragma unroll
        for (int e = 0; e < 16; ++e) rv[e] = (t1 + e * NP + cv)[voff]; }
    { bf16_t* vp = t0 + (vj >> 1) * NP + cv + (vj & 1) * 64 + vq * 16; *(u32x4*)vp = w0; *(u32x4*)(vp + 8) = w1; }
    float prefix = 0.f, bm = 0.f, blast = 0.f;
#pragma unroll
    for (int q2 = 0; q2 < NPQ; ++q2) { const float v = cs[q2 * DK + k]; if (q2 < pq) prefix += v; if (q2 < NPQ / 2) bm += v; blast += v; }
    { const int kperm = 32 * (k >> 5) + 8 * ((k >> 2) & 3) + 4 * ((k >> 4) & 1) + (k & 3);
      const unsigned qoff = (unsigned)(pq * PL) * NP + kperm;
      unsigned ktp[PL / 2];
#pragma unroll
      for (int e = 0; e < PL; e += 2) {
          const float b0 = prefix + bl_[e], b1 = prefix + bl_[e + 1];
          const float q0 = qq[e] * __expf(fminf(b0 - bm, 80.f)), q1 = qq[e + 1] * __expf(fminf(b1 - bm, 80.f));
          const float k0 = kk[e] * __expf(fminf(bm - b0, 80.f)), k1 = kk[e + 1] * __expf(fminf(bm - b1, 80.f));
          const unsigned qp = cvt_pk_bf16(q0, q1), kp = cvt_pk_bf16(k0, k1);
          const int p0 = pq * PL + e;
          *(LAS bf16_t*)(lds + CA_QT + p0 * QS + k * 2) = (bf16_t)(qp & 0xffffu); *(LAS bf16_t*)(lds + CA_QT + (p0 + 1) * QS + k * 2) = (bf16_t)(qp >> 16);
          *(LAS bf16_t*)(lds + CA_KT + p0 * QS + k * 2) = (bf16_t)(kp & 0xffffu); *(LAS bf16_t*)(lds + CA_KT + (p0 + 1) * QS + k * 2) = (bf16_t)(kp >> 16);
          (t0 + e * NP + cq)[qoff] = (bf16_t)(qp & 0xffffu); (t0 + (e + 1) * NP + cq)[qoff] = (bf16_t)(qp >> 16);
          ktp[e / 2] = kp; }
      bf16_t* kp_ = GLA ? (t0 + k * NP + ckt + pq * PL) : (t0 + (k >> 1) * NP + ckt + (k & 1) * 64 + pq * PL);
#pragma unroll
      for (int e = 0; e < PL / 8; ++e) { u32x4 wv; wv.x = ktp[e * 4]; wv.y = ktp[e * 4 + 1]; wv.z = ktp[e * 4 + 2]; wv.w = ktp[e * 4 + 3]; *(u32x4*)(kp_ + e * 8) = wv; } }
    if (pq == 0) { float* ec = esc + (size_t)cc * 3 * DK; ec[k] = __expf(bm); ec[DK + k] = __expf(blast - bm); ec[2 * DK + k] = __expf(blast); }
    LDS_BAR();
    const unsigned poff = (unsigned)(4 * fq) * NP + fr;
#pragma unroll
    for (int rep = 0; rep < 2; ++rep) { const int id = w + rep * 8, it = id >> 2, jt = id & 3;
        f32x4 pa = (f32x4){0.f, 0.f, 0.f, 0.f};
        if (jt <= it) {
#pragma unroll
            for (int ks = 0; ks < KS; ++ks) { const bf16x8 a = *(const LAS bf16x8*)(lds + CA_QT + (it * 16 + fr) * QS + (ks * 32 + fq * 8) * 2);
                const bf16x8 b = *(const LAS bf16x8*)(lds + CA_KT + (jt * 16 + fr) * QS + (ks * 32 + fq * 8) * 2); pa = MFMA16(a, b, pa); }
            if (jt == it) {
#pragma unroll
                for (int jj = 0; jj < 4; ++jj) if (fr > 4 * fq + jj) pa[jj] = 0.f; } }
#pragma unroll
        for (int jj = 0; jj < 4; ++jj) (t0 + (it * 16 + jj) * NP + cp + jt * 16)[poff] = f2bf(pa[jj]); }
    LDS_BAR();
  }
}

constexpr int CH_BUF = 66560;
template <int DK, bool GLA>
__device__ void chain_attn(LAS unsigned char* lds, bf16_t* proj, const int bl, const int h, const float* esc, const int vc_base, const int nwv) {
    constexpr int QS = (DK + 8) * 2, TS = 144, MT = DK / 16, KS = DK / 32, QPR = DK / 8  ;
    constexpr int O_QT = 0, O_P = 17408, O_KTT = 26624, O_VT = 45056, O_ESC = 63488;
    constexpr int NQ = 64 * QPR, NPP = 512, NK = DK * 8, NV = 1024, NE = 3 * DK / 4;
    const int tid = opaque_tid(), lane = tid & 63, w = __builtin_amdgcn_readfirstlane(tid >> 6), fr = lane & 15, fq = lane >> 4;
    const int cq = GLA ? (C_GQ + h * 64) : (C_HQ + h * 128), ckt = GLA ? (C_GK + h * 64) : (C_HF + h * 128);
    const int cv = (GLA ? C_GV : C_HI) + h * 128, cp = (GLA ? C_GKL : C_PA) + h * 64;
    bf16_t* base = proj + (size_t)bl * SEQ * NP;
    f32x4 Sacc[MT];
#pragma unroll
    for (int m = 0; m < MT; ++m) Sacc[m] = (f32x4){0.f, 0.f, 0.f, 0.f};
    u32x4 sq[2][NQ / 512], sp[2], sk[2][NK / 512], sv[2][2], se[2];
#define CH_OFFS() \
    int t_ = tid; asm volatile("" : "+v"(t_)); \
    unsigned gq[NQ / 512], lq[NQ / 512], gk[NK / 512], lk[NK / 512], gv[2], lv[2], gp, lp; \
    _Pragma("unroll") for (int i = 0; i < NQ / 512; ++i) { const int pc = t_ + i * 512, row = pc / QPR, c8 = pc % QPR; gq[i] = (unsigned)row * NP + cq + c8 * 8; lq[i] = O_QT + row * QS + c8 * 16; } \
    { const int row = t_ >> 3, c8 = t_ & 7; gp = (unsigned)row * NP + cp + c8 * 8; lp = O_P + row * TS + c8 * 16; } \
    _Pragma("unroll") for (int i = 0; i < NK / 512; ++i) { const int pc = t_ + i * 512; \
        if (GLA) { const int kk = pc >> 3, t8 = pc & 7; gk[i] = (unsigned)kk * NP + ckt + t8 * 8; lk[i] = O_KTT + kk * TS + t8 * 16; } \
        else { const int grow = pc >> 4, c16 = pc & 15, kk = 2 * grow + (c16 >> 3); gk[i] = (unsigned)grow * NP + ckt + c16 * 8; lk[i] = O_KTT + kk * TS + (c16 & 7) * 16; } } \
    _Pragma("unroll") for (int i = 0; i < 2; ++i) { const int pc = t_ + i * 512, grow = pc >> 4, c16 = pc & 15, v = 2 * grow + (c16 >> 3); gv[i] = (unsigned)grow * NP + cv + c16 * 8; lv[i] = O_VT + v * TS + (c16 & 7) * 16; }
#define CH_LOAD(S, cc) do { CH_OFFS(); (void)lq; (void)lk; (void)lv; (void)lp; const bf16_t* tb_ = base + (size_t)(cc) * 64 * NP; \
        _Pragma("unroll") for (int i = 0; i < NQ / 512; ++i) sq[S][i] = *(const u32x4*)(tb_ + gq[i]); \
        sp[S] = *(const u32x4*)(tb_ + gp); \
        _Pragma("unroll") for (int i = 0; i < NK / 512; ++i) sk[S][i] = *(const u32x4*)(tb_ + gk[i]); \
        _Pragma("unroll") for (int i = 0; i < 2; ++i) sv[S][i] = *(const u32x4*)(tb_ + gv[i]); \
        if (t_ < NE) se[S] = *(const u32x4*)(esc + (size_t)(cc) * 3 * DK + t_ * 4); } while (0)
#define CH_STORE(S, bufo) do { CH_OFFS(); (void)gq; (void)gk; (void)gv; (void)gp; \
        _Pragma("unroll") for (int i = 0; i < NQ / 512; ++i) *(LAS u32x4*)(lds + (bufo) + lq[i]) = sq[S][i]; \
        *(LAS u32x4*)(lds + (bufo) + lp) = sp[S]; \
        _Pragma("unroll") for (int i = 0; i < NK / 512; ++i) *(LAS u32x4*)(lds + (bufo) + lk[i]) = sk[S][i]; \
        _Pragma("unroll") for (int i = 0; i < 2; ++i) *(LAS u32x4*)(lds + (bufo) + lv[i]) = sv[S][i]; \
        if (t_ < NE) *(LAS u32x4*)(lds + (bufo) + O_ESC + t_ * 16) = se[S]; } while (0)
#define CH_STEP(S, c) do { \
        const int bo = ((c) & 1) * CH_BUF; \
        if (w < nwv) { \
        LAS float* e1 = (LAS float*)(lds + bo + O_ESC); LAS float* e2 = e1 + DK; LAS float* dd = e1 + 2 * DK; \
        bf16x8 Bv[2], Sb[KS]; \
        _Pragma("unroll") for (int ks = 0; ks < 2; ++ks) Bv[ks] = *(const LAS bf16x8*)(lds + bo + O_VT + (vc0 + fr) * TS + (ks * 32 + fq * 8) * 2); \
        _Pragma("unroll") for (int ks = 0; ks < KS; ++ks) { const f32x4 ea = *(const LAS f32x4*)(e1 + (2 * ks) * 16 + 4 * fq), eb = *(const LAS f32x4*)(e1 + (2 * ks + 1) * 16 + 4 * fq); \
            const f32x4 sa = Sacc[2 * ks] * ea, sb = Sacc[2 * ks + 1] * eb; \
            u32x4 wv; wv.x = cvt_pk_bf16(sa[0], sa[1]); wv.y = cvt_pk_bf16(sa[2], sa[3]); wv.z = cvt_pk_bf16(sb[0], sb[1]); wv.w = cvt_pk_bf16(sb[2], sb[3]); \
            __builtin_memcpy(&Sb[ks], &wv, 16); } \
        bf16_t* tb = base + (size_t)(c) * 64 * NP; \
        bf16_t* op = tb + ((vc0 >> 1) + (fr >> 1)) * NP + cv + (fr & 1) * 64 + 4 * fq; \
        _Pragma("unroll") for (int m = 0; m < 4; ++m) { f32x4 a4 = (f32x4){0.f, 0.f, 0.f, 0.f}; \
            _Pragma("unroll") for (int ks = 0; ks < 2; ++ks) { if (ks == 1 && m < 2) continue; \
                const bf16x8 a = *(const LAS bf16x8*)(lds + bo + O_P + (m * 16 + fr) * TS + (ks * 32 + fq * 8) * 2); a4 = MFMA16(a, Bv[ks], a4); } \
            _Pragma("unroll") for (int ks = 0; ks < KS; ++ks) { const bf16x8 a = *(const LAS bf16x8*)(lds + bo + O_QT + (m * 16 + fr) * QS + (ks * 32 + fq * 8) * 2); a4 = MFMA16(a, Sb[ks], a4); } \
            u32x2 ow; ow.x = cvt_pk_bf16(a4[0], a4[1]); ow.y = cvt_pk_bf16(a4[2], a4[3]); \
            *(u32x2*)(op + m * 16) = ow; } \
        _Pragma("unroll") for (int m = 0; m < MT; ++m) { f32x4 t4 = (f32x4){0.f, 0.f, 0.f, 0.f}; \
            _Pragma("unroll") for (int ks = 0; ks < 2; ++ks) { const bf16x8 a = *(const LAS bf16x8*)(lds + bo + O_KTT + (m * 16 + fr) * TS + (ks * 32 + fq * 8) * 2); t4 = MFMA16(a, Bv[ks], t4); } \
            const f32x4 d4 = *(const LAS f32x4*)(dd + m * 16 + 4 * fq), e4 = *(const LAS f32x4*)(e2 + m * 16 + 4 * fq); \
            Sacc[m] = Sacc[m] * d4 + t4 * e4; } } \
        if ((c) < 63) CH_STORE(S, (((c) + 1) & 1) * CH_BUF); \
        if ((c) < 61) CH_LOAD(S, (c) + 3); \
        LDS_BAR(); } while (0)
    const int vc0 = vc_base + 16 * w;
    CH_LOAD(0, 0); CH_STORE(0, 0);
    CH_LOAD(0, 1); CH_LOAD(1, 2);
    LDS_BAR();
    for (int c = 0; c < 64; c += 2) {
        CH_STEP(0, c);
        CH_STEP(1, c + 1);
    }
#undef CH_LOAD
#undef CH_STORE
#undef CH_STEP
#undef CH_OFFS
}

__device__ void chain_hg_half(LAS unsigned char* lds, bf16_t* proj, const int bl, const int h, const float* esc, const int vc_base) {
    constexpr int DK = 128, QS = 272, TS = 144, MT = 8, KS = 4;
    constexpr int O_QT = 0, O_P = 17408, O_KTT = 26624, O_VT = 45056, O_ESC = 63488;
    const int tid = opaque_tid(), lane = tid & 63, w = __builtin_amdgcn_readfirstlane(tid >> 6), fr = lane & 15, fq = lane >> 4;
    const int cq = C_HQ + h * 128, ckt = C_HF + h * 128, cv = C_HI + h * 128, cp = C_PA + h * 64;
    bf16_t* base = proj + (size_t)bl * SEQ * NP;
    if (w >= 4) {
        const int lt = tid - 256;
        u32x4 r[3][13];
#define HL_OFFS() \
        int t_ = lt; asm volatile("" : "+v"(t_)); unsigned go[13], lo[13]; \
        _Pragma("unroll") for (int i = 0; i < 4; ++i) { const int pc = t_ + i * 256, row = pc >> 4, c8 = pc & 15; go[i] = (unsigned)row * NP + cq + c8 * 8; lo[i] = O_QT + row * QS + c8 * 16; } \
        _Pragma("unroll") for (int i = 0; i < 2; ++i) { const int pc = t_ + i * 256, row = pc >> 3, c8 = pc & 7; go[4 + i] = (unsigned)row * NP + cp + c8 * 8; lo[4 + i] = O_P + row * TS + c8 * 16; } \
        _Pragma("unroll") for (int i = 0; i < 4; ++i) { const int pc = t_ + i * 256, grow = pc >> 4, c16 = pc & 15, kk = 2 * grow + (c16 >> 3); go[6 + i] = (unsigned)grow * NP + ckt + c16 * 8; lo[6 + i] = O_KTT + kk * TS + (c16 & 7) * 16; } \
        _Pragma("unroll") for (int i = 0; i < 2; ++i) { const int pc = t_ + i * 256, grow = (vc_base >> 1) + (pc >> 4), c16 = pc & 15, v = 2 * grow + (c16 >> 3); go[10 + i] = (unsigned)grow * NP + cv + c16 * 8; lo[10 + i] = O_VT + v * TS + (c16 & 7) * 16; }
#define HL_LOAD(S, cc) do { HL_OFFS(); (void)lo; const bf16_t* tb_ = base + (size_t)(cc) * 64 * NP; \
        _Pragma("unroll") for (int i = 0; i < 12; ++i) r[S][i] = *(const u32x4*)(tb_ + go[i]); \
        if (t_ < 96) r[S][12] = *(const u32x4*)(esc + (size_t)(cc) * 3 * DK + t_ * 4); } while (0)
#define HL_STORE(S, bufo) do { HL_OFFS(); (void)go; \
        _Pragma("unroll") for (int i = 0; i < 12; ++i) *(LAS u32x4*)(lds + (bufo) + lo[i]) = r[S][i]; \
        if (t_ < 96) *(LAS u32x4*)(lds + (bufo) + O_ESC + t_ * 16) = r[S][12]; } while (0)
#define HL_STEP(S, c) do { if ((c) < 63) HL_STORE(S, (((c) + 1) & 1) * CH_BUF); if ((c) + 4 < 64) HL_LOAD(S, (c) + 4); LDS_BAR(); } while (0)
        HL_LOAD(0, 0); HL_STORE(0, 0);
        HL_LOAD(0, 1); HL_LOAD(1, 2); HL_LOAD(2, 3);
        LDS_BAR();
        for (int c = 0; c < 63; c += 3) { HL_STEP(0, c); HL_STEP(1, c + 1); HL_STEP(2, c + 2); }
        HL_STEP(0, 63);
#undef HL_OFFS
#undef HL_LOAD
#undef HL_STORE
#undef HL_STEP
    } else {
        const int vc0 = vc_base + 16 * w;
        f32x4 Sacc[MT];
#pragma unroll
        for (int m = 0; m < MT; ++m) Sacc[m] = (f32x4){0.f, 0.f, 0.f, 0.f};
        LDS_BAR();
        for (int c = 0; c < 64; ++c) {
            const int bo = (c & 1) * CH_BUF;
            LAS float* e1 = (LAS float*)(lds + bo + O_ESC); LAS float* e2 = e1 + DK; LAS float* dd = e1 + 2 * DK;
            bf16x8 Bv[2], Sb[KS];
#pragma unroll
            for (int ks = 0; ks < 2; ++ks) Bv[ks] = *(const LAS bf16x8*)(lds + bo + O_VT + (vc0 + fr) * TS + (ks * 32 + fq * 8) * 2);
#pragma unroll
            for (int ks = 0; ks < KS; ++ks) { const f32x4 ea = *(const LAS f32x4*)(e1 + (2 * ks) * 16 + 4 * fq), eb = *(const LAS f32x4*)(e1 + (2 * ks + 1) * 16 + 4 * fq);
                const f32x4 sa = Sacc[2 * ks] * ea, sb = Sacc[2 * ks + 1] * eb;
                u32x4 wv; wv.x = cvt_pk_bf16(sa[0], sa[1]); wv.y = cvt_pk_bf16(sa[2], sa[3]); wv.z = cvt_pk_bf16(sb[0], sb[1]); wv.w = cvt_pk_bf16(sb[2], sb[3]);
                __builtin_memcpy(&Sb[ks], &wv, 16); }
            bf16_t* tb = base + (size_t)c * 64 * NP;
            bf16_t* op = tb + ((vc0 >> 1) + (fr >> 1)) * NP + cv + (fr & 1) * 64 + 4 * fq;
#pragma unroll
            for (int m = 0; m < 4; ++m) { f32x4 a4 = (f32x4){0.f, 0.f, 0.f, 0.f};
#pragma unroll
                for (int ks = 0; ks < 2; ++ks) { if (ks == 1 && m < 2) continue;
                    const bf16x8 a = *(const LAS bf16x8*)(lds + bo + O_P + (m * 16 + fr) * TS + (ks * 32 + fq * 8) * 2); a4 = MFMA16(a, Bv[ks], a4); }
#pragma unroll
                for (int ks = 0; ks < KS; ++ks) { const bf16x8 a = *(const LAS bf16x8*)(lds + bo + O_QT + (m * 16 + fr) * QS + (ks * 32 + fq * 8) * 2); a4 = MFMA16(a, Sb[ks], a4); }
                u32x2 ow; ow.x = cvt_pk_bf16(a4[0], a4[1]); ow.y = cvt_pk_bf16(a4[2], a4[3]);
                *(u32x2*)(op + m * 16) = ow; }
#pragma unroll
            for (int m = 0; m < MT; ++m) { f32x4 t4 = (f32x4){0.f, 0.f, 0.f, 0.f};
#pragma unroll
                for (int ks = 0; ks < 2; ++ks) { const bf16x8 a = *(const LAS bf16x8*)(lds + bo + O_KTT + (m * 16 + fr) * TS + (ks * 32 + fq * 8) * 2); t4 = MFMA16(a, Bv[ks], t4); }
                const f32x4 d4 = *(const LAS f32x4*)(dd + m * 16 + 4 * fq), e4 = *(const LAS f32x4*)(e2 + m * 16 + 4 * fq);
                Sacc[m] = Sacc[m] * d4 + t4 * e4; }
            LDS_BAR();
        }
    }
}

__device__ void post_attn(LAS unsigned char* lds, bf16_t* proj, const int bl, const int h, const int c, const bool gla, const float* nwp) {
    const int tid = opaque_tid();
    const int cv = (gla ? C_GV : C_HI) + h * 128, cg = (gla ? C_GG : C_HG) + h * 128;
    bf16_t* t0 = proj + ((size_t)bl * SEQ + (size_t)c * 64) * NP;
    LAS float* ot = (LAS float*)lds;
    {
#pragma unroll
      for (int i = 0; i < 2; ++i) { const int pc = tid + i * 512, grow = pc >> 4, c16 = pc & 15, v = 2 * grow + (c16 >> 3), tk = (c16 & 7) * 8;
          const u32x4 x = *(const u32x4*)(t0 + (unsigned)grow * NP + cv + c16 * 8);
          ot[(tk + 0) * 132 + v] = __uint_as_float(x.x << 16); ot[(tk + 1) * 132 + v] = __uint_as_float(x.x & 0xffff0000u);
          ot[(tk + 2) * 132 + v] = __uint_as_float(x.y << 16); ot[(tk + 3) * 132 + v] = __uint_as_float(x.y & 0xffff0000u);
          ot[(tk + 4) * 132 + v] = __uint_as_float(x.z << 16); ot[(tk + 5) * 132 + v] = __uint_as_float(x.z & 0xffff0000u);
          ot[(tk + 6) * 132 + v] = __uint_as_float(x.w << 16); ot[(tk + 7) * 132 + v] = __uint_as_float(x.w & 0xffff0000u); } }
    LDS_BAR();
    const int tok = tid >> 3, v8 = tid & 7;
    f32x4 o[4]; float s = 0.f;
#pragma unroll
    for (int i = 0; i < 4; ++i) { o[i] = *(const LAS f32x4*)(ot + tok * 132 + v8 * 16 + i * 4); s += o[i][0] * o[i][0] + o[i][1] * o[i][1] + o[i][2] * o[i][2] + o[i][3] * o[i][3]; }
    s += __shfl_xor(s, 1); s += __shfl_xor(s, 2); s += __shfl_xor(s, 4);
    const float rs = rsqrtf(s * (1.0f / 128.0f) + NORM_EPS);
    bf16_t* gp = t0 + (unsigned)tok * NP + cg + v8 * 16;
    const u32x4 g0 = *(const u32x4*)gp, g1 = *(const u32x4*)(gp + 8);
    const unsigned gw[8] = {g0.x, g0.y, g0.z, g0.w, g1.x, g1.y, g1.z, g1.w};
    unsigned yw[8];
#pragma unroll
    for (int i = 0; i < 8; ++i) { const float ga = __uint_as_float(gw[i] << 16), gb = __uint_as_float(gw[i] & 0xffff0000u);
        const float oa = o[i >> 1][(i & 1) * 2], ob = o[i >> 1][(i & 1) * 2 + 1];
        const float na = nwp[v8 * 16 + i * 2], nb = nwp[v8 * 16 + i * 2 + 1];
        yw[i] = cvt_pk_bf16(oa * rs * na * silu(ga), ob * rs * nb * silu(gb)); }
    u32x4 y0, y1; y0.x = yw[0]; y0.y = yw[1]; y0.z = yw[2]; y0.w = yw[3]; y1.x = yw[4]; y1.y = yw[5]; y1.z = yw[6]; y1.w = yw[7];
    *(u32x4*)gp = y0; *(u32x4*)(gp + 8) = y1;
    LDS_BAR();
}

template <int M0, int NKT>
__device__ __forceinline__ void sg_pass(LAS unsigned char* lds, bf16_t* t0, const float* w_s, const float* b_s, const int g, const int cb, const int fr, const int fq) {
    constexpr int VS = 272;
    f32x4 acc[4][4];
#pragma unroll
    for (int m = 0; m < 4; ++m)
#pragma unroll
        for (int n = 0; n < 4; ++n) acc[m][n] = (f32x4){0.f, 0.f, 0.f, 0.f};
    const unsigned aoff = (unsigned)fr * 128 + fq * 8;
    const float* wbase = w_s + (g * 128 + M0 * 16) * 128;
    f32x4 nf[4][2];
#pragma unroll
    for (int m = 0; m < 4; ++m) { const float* wp = wbase + m * 16 * 128; nf[m][0] = *(const f32x4*)(wp + aoff); nf[m][1] = *(const f32x4*)(wp + aoff + 4); }
#pragma unroll
    for (int kt = 0; kt < NKT; ++kt) { bf16x8 B[4], A[4];
#pragma unroll
        for (int m = 0; m < 4; ++m) { u32x4 aw; aw.x = cvt_pk_bf16(nf[m][0][0], nf[m][0][1]); aw.y = cvt_pk_bf16(nf[m][0][2], nf[m][0][3]); aw.z = cvt_pk_bf16(nf[m][1][0], nf[m][1][1]); aw.w = cvt_pk_bf16(nf[m][1][2], nf[m][1][3]);
            __builtin_memcpy(&A[m], &aw, 16); }
        if (kt + 1 < NKT) {
#pragma unroll
            for (int m = 0; m < 4; ++m) { const float* wp = wbase + m * 16 * 128 + (kt + 1) * 32; nf[m][0] = *(const f32x4*)(wp + aoff); nf[m][1] = *(const f32x4*)(wp + aoff + 4); } }
#pragma unroll
        for (int n = 0; n < 4; ++n) B[n] = *(const LAS bf16x8*)(lds + (cb + n * 16 + fr) * VS + (kt * 32 + fq * 8) * 2);
#pragma unroll
        for (int m = 0; m < 4; ++m)
#pragma unroll
            for (int n = 0; n < 4; ++n) acc[m][n] = MFMA16(A[m], B[n], acc[m][n]); }
    const unsigned roff = (unsigned)(4 * fq) * NP + fr;
#pragma unroll
    for (int m = 0; m < 4; ++m)
#pragma unroll
        for (int jj = 0; jj < 4; ++jj) { const float bs = b_s[g * 128 + (M0 + m) * 16 + 4 * fq + jj]; bf16_t* rp = t0 + ((M0 + m) * 16 + jj) * NP + C_SV + cb;
#pragma unroll
            for (int n = 0; n < 4; ++n) (rp + n * 16)[roff] = f2bf(acc[m][n][jj] + bs); }
}
__device__ void sg_unit(LAS unsigned char* lds, bf16_t* proj, const int tok0, const float* ln_w, const float* ln_b, const float* w_s, const float* b_s) {
    constexpr int VS = 272;
    const int tid = opaque_tid(), lane = tid & 63, w = __builtin_amdgcn_readfirstlane(tid >> 6), fr = lane & 15, fq = lane >> 4;
    bf16_t* t0 = proj + (size_t)tok0 * NP;
    {   float lw[8], lbv[8];
#pragma unroll
        for (int e = 0; e < 8; ++e) { lw[e] = ln_w[lane + 64 * e]; lbv[e] = ln_b[lane + 64 * e]; }
        bf16_t rv[4][8];
#pragma unroll
        for (int s = 0; s < 4; ++s)
#pragma unroll
            for (int e = 0; e < 8; ++e) rv[s][e] = (t0 + (w * 16 + s) * NP + C_SV + 64 * e)[(unsigned)lane];
        for (int it = 0; it < 4; ++it) { float x[4][8], sm[4], sq[4];
#pragma unroll
            for (int s = 0; s < 4; ++s) { sm[s] = 0.f; sq[s] = 0.f;
#pragma unroll
                for (int e = 0; e < 8; ++e) { x[s][e] = gelu_erf(bf2f(rv[s][e])); sm[s] += x[s][e]; sq[s] += x[s][e] * x[s][e]; } }
            if (it < 3) {
#pragma unroll
                for (int s = 0; s < 4; ++s)
#pragma unroll
                    for (int e = 0; e < 8; ++e) rv[s][e] = (t0 + (w * 16 + (it + 1) * 4 + s) * NP + C_SV + 64 * e)[(unsigned)lane]; }
#pragma unroll
            for (int o = 32; o >= 1; o >>= 1) {
#pragma unroll
                for (int s = 0; s < 4; ++s) { sm[s] += __shfl_xor(sm[s], o); sq[s] += __shfl_xor(sq[s], o); } }
#pragma unroll
            for (int s = 0; s < 4; ++s) { const float mu = sm[s] * (1.0f / 512.0f); const float var = fmaxf(sq[s] * (1.0f / 512.0f) - mu * mu, 0.f); const float rs = rsqrtf(var + NORM_EPS);
#pragma unroll
                for (int e = 0; e < 8; ++e) x[s][e] = (x[s][e] - mu) * rs * lw[e] + lbv[e]; }
#pragma unroll
            for (int e = 0; e < 8; ++e) { LAS unsigned* dp = (LAS unsigned*)(lds + (lane + 64 * e) * VS + (w * 16 + it * 4) * 2);
                dp[0] = cvt_pk_bf16(x[0][e], x[1][e]); dp[1] = cvt_pk_bf16(x[2][e], x[3][e]); } } }
    LDS_BAR();
    const int g = w >> 1, cb = g * 128 + (w & 1) * 64;
    sg_pass<0, 2>(lds, t0, w_s, b_s, g, cb, fr, fq);
    sg_pass<4, 4>(lds, t0, w_s, b_s, g, cb, fr, fq);
    LDS_BAR();
}
__device__ void sg_post(bf16_t* proj, const int tok0) {
    const int tid = opaque_tid(); const int c8 = tid & 63, tr = tid >> 6;
    bf16_t* t0 = proj + ((size_t)tok0 + tr * 8) * NP + c8 * 8;
#pragma unroll
    for (int e = 0; e < 8; ++e) { bf16_t* gp = t0 + e * NP + C_SGT;
        const u32x4 uu = *(const u32x4*)(t0 + e * NP + C_SU), mm = *(const u32x4*)(t0 + e * NP + C_SV), gg = *(const u32x4*)gp;
        const unsigned ua[4] = {uu.x, uu.y, uu.z, uu.w}, ma[4] = {mm.x, mm.y, mm.z, mm.w}, ga[4] = {gg.x, gg.y, gg.z, gg.w}; unsigned o[4];
#pragma unroll
        for (int i = 0; i < 4; ++i) { const float u0 = __uint_as_float(ua[i] << 16), u1 = __uint_as_float(ua[i] & 0xffff0000u), m0 = __uint_as_float(ma[i] << 16), m1 = __uint_as_float(ma[i] & 0xffff0000u);
            const float g0 = __uint_as_float(ga[i] << 16), g1 = __uint_as_float(ga[i] & 0xffff0000u);
            o[i] = cvt_pk_bf16(gelu_erf(u0) * m0 * silu(g0), gelu_erf(u1) * m1 * silu(g1)); }
        u32x4 ov; ov.x = o[0]; ov.y = o[1]; ov.z = o[2]; ov.w = o[3]; *(u32x4*)gp = ov; }
}

constexpr int LR_XCB = 0, LR_XCF = 17408, LR_SA = 50176, LR_SB = 82944, LR_CA = 115712  , LR_CH = 117760;
__device__ void lru_prep(LAS unsigned char* lds, bf16_t* proj, const int bl, const int h, const int c0, const float* conv_w, const float* conv_b, const float* w_a, const float* b_a,
                         const float* w_x, const float* b_x, const float* lam, float* car  ) {
    const int tid = opaque_tid(), lane = tid & 63, w = __builtin_amdgcn_readfirstlane(tid >> 6), fr = lane & 15, fq = lane >> 4;
    const int ci = tid & 127, tq = tid >> 7; const int ch = h * 128 + ci;
    float cw[4]; const float cbias = conv_b[ch];
#pragma unroll
    for (int t = 0; t < 4; ++t) cw[t] = conv_w[t * 512 + ch];
    const int jch = h * 128 + w * 16 + fr;
    const float ba = b_a[jch], bx = b_x[jch];
    float c8; { const float nl = -lam[jch]; const float sp = fmaxf(nl, 0.f) + __logf(1.0f + __expf(-fabsf(nl))); c8 = -8.0f * sp; }
    bf16x8 Ba[4], Bx[4];
    { const int j = w * 16 + fr;
#pragma unroll
      for (int ks = 0; ks < 4; ++ks) { float fa[8], fx[8];
#pragma unroll
          for (int e = 0; e < 8; ++e) { const unsigned o = (unsigned)(h * 128 + ks * 32 + fq * 8 + e) * 128 + j; fa[e] = w_a[o]; fx[e] = w_x[o]; }
          u32x4 wa, wx; wa.x = cvt_pk_bf16(fa[0], fa[1]); wa.y = cvt_pk_bf16(fa[2], fa[3]); wa.z = cvt_pk_bf16(fa[4], fa[5]); wa.w = cvt_pk_bf16(fa[6], fa[7]);
          wx.x = cvt_pk_bf16(fx[0], fx[1]); wx.y = cvt_pk_bf16(fx[2], fx[3]); wx.z = cvt_pk_bf16(fx[4], fx[5]); wx.w = cvt_pk_bf16(fx[6], fx[7]);
          __builtin_memcpy(&Ba[ks], &wa, 16); __builtin_memcpy(&Bx[ks], &wx, 16); } }
    LAS float* xcf = (LAS float*)(lds + LR_XCF); LAS float* sa = (LAS float*)(lds + LR_SA); LAS float* sb = (LAS float*)(lds + LR_SB);
    LAS float* ca = (LAS float*)(lds + LR_CA); LAS float* chh = (LAS float*)(lds + LR_CH);
    bf16_t* base = proj + (size_t)bl * SEQ * NP;
    const int xoff = (tq * 16) * NP + ch;
    bf16_t xr[19], rgt[16];
#pragma unroll
    for (int e = 0; e < 19; ++e) { const int s = c0 * 64 + tq * 16 - 3 + e; xr[e] = (s >= 0) ? (base + (c0 * 64 - 3 + e) * NP + C_RX)[xoff] : (bf16_t)0; }
#pragma unroll
    for (int e = 0; e < 16; ++e) rgt[e] = (base + (c0 * 64 + e) * NP + C_RG)[xoff];
  for (int cc = 0; cc < PREP_NCH; ++cc) { const int c = c0 + cc;
    bf16_t* t0 = base + (size_t)c * 64 * NP;
    { float xv[19];
#pragma unroll
        for (int e = 0; e < 19; ++e) xv[e] = bf2f(xr[e]);
#pragma unroll
        for (int e = 0; e < 16; ++e) { const float xc = cbias + cw[0] * xv[e] + cw[1] * xv[e + 1] + cw[2] * xv[e + 2] + cw[3] * xv[e + 3]; const int t = tq * 16 + e;
            xcf[t * 128 + ci] = xc; *(LAS bf16_t*)(lds + LR_XCB + t * 272 + ci * 2) = f2bf(xc); } }
    float sg[16];
#pragma unroll
    for (int e = 0; e < 16; ++e) sg[e] = silu(bf2f(rgt[e]));
    LDS_BAR();
    if (cc + 1 < PREP_NCH) {
#pragma unroll
        for (int e = 0; e < 19; ++e) xr[e] = (t0 + (64 - 3 + e) * NP + C_RX)[xoff];
#pragma unroll
        for (int e = 0; e < 16; ++e) rgt[e] = (t0 + (64 + e) * NP + C_RG)[xoff]; }
#pragma unroll
    for (int m = 0; m < 4; ++m) { f32x4 aa = (f32x4){0.f, 0.f, 0.f, 0.f}, ax = aa;
#pragma unroll
        for (int ks = 0; ks < 4; ++ks) { const bf16x8 a = *(const LAS bf16x8*)(lds + LR_XCB + (m * 16 + fr) * 272 + (ks * 32 + fq * 8) * 2); aa = MFMA16(a, Ba[ks], aa); ax = MFMA16(a, Bx[ks], ax); }
#pragma unroll
        for (int jj = 0; jj < 4; ++jj) { const int t = m * 16 + 4 * fq + jj; const float r = sigm(aa[jj] + ba), ig = sigm(ax[jj] + bx);
            const float la = c8 * r; const float av = __expf(la); const float x2 = 2.0f * la;
            const float om = (x2 > -0.02f) ? -x2 * (1.0f + x2 * (0.5f + x2 * (1.0f / 6.0f))) : 1.0f - __expf(x2);
            const float bt = sqrtf(fmaxf(om, 1e-12f)) * ig * xcf[t * 128 + w * 16 + fr];
            sa[t * 128 + w * 16 + fr] = av; sb[t * 128 + w * 16 + fr] = bt; } }
    LDS_BAR();
    float hl[16], ac[16]; { float hloc = 0.f, A = 1.f;
#pragma unroll
        for (int e = 0; e < 16; ++e) { const float a = sa[(tq * 16 + e) * 128 + ci], b = sb[(tq * 16 + e) * 128 + ci]; hloc = a * hloc + b; A *= a; hl[e] = hloc; ac[e] = A; }
        ca[tq * 128 + ci] = A; chh[tq * 128 + ci] = hloc; }
    LDS_BAR();
    { float Hq = 0.f, Hn = 0.f, Aq = 1.f, An = 1.f;
#pragma unroll
        for (int q2 = 0; q2 < 4; ++q2) { const float A = ca[q2 * 128 + ci], hh = chh[q2 * 128 + ci]; Hn = A * Hn + hh; An *= A; if (q2 < tq) { Hq = Hn; Aq = An; } }
        if (tq == 0) { f32x2 cv2 = {An, Hn}; *(f32x2*)(car + ((size_t)c * 512 + ch) * 2) = cv2; }
#pragma unroll
        for (int e = 0; e < 16; ++e) { const float hv = hl[e] + ac[e] * Hq;
            (t0 + e * NP + C_RG)[xoff] = f2bf(hv * sg[e]); (t0 + e * NP + C_Z)[xoff] = f2bf(ac[e] * Aq * sg[e]); } }
    LDS_BAR();
  }
}
__device__ void lru_scan(const float* car, float* hin) {
    const int ch = opaque_tid(); float H = 0.f;
    for (int c = 0; c < 64; c += 8) { f32x2 v[8];
#pragma unroll
        for (int e = 0; e < 8; ++e) v[e] = *(const f32x2*)(car + ((size_t)(c + e) * 512 + ch) * 2);
#pragma unroll
        for (int e = 0; e < 8; ++e) { hin[(size_t)(c + e) * 512 + ch] = H; H = v[e][0] * H + v[e][1]; } }
}
__device__ void lru_post(bf16_t* proj, const int bl, const int c, const float* hin  ) {
    const int tid = opaque_tid(); const int c8 = tid & 63, tr = tid >> 6;
    bf16_t* t0 = proj + ((size_t)bl * SEQ + (size_t)c * 64 + tr * 8) * NP;
    const f32x4 h0 = *(const f32x4*)(hin + (size_t)c * 512 + c8 * 8), h1 = *(const f32x4*)(hin + (size_t)c * 512 + c8 * 8 + 4);
#pragma unroll
    for (int e = 0; e < 8; ++e) { bf16_t* yp = t0 + e * NP + C_RG + c8 * 8; const bf16_t* zp = t0 + e * NP + C_Z + c8 * 8;
        const u32x4 y = *(const u32x4*)yp, z = *(const u32x4*)zp; u32x4 o;
        o.x = cvt_pk_bf16(__uint_as_float(y.x << 16) + __uint_as_float(z.x << 16) * h0[0], __uint_as_float(y.x & 0xffff0000u) + __uint_as_float(z.x & 0xffff0000u) * h0[1]);
        o.y = cvt_pk_bf16(__uint_as_float(y.y << 16) + __uint_as_float(z.y << 16) * h0[2], __uint_as_float(y.y & 0xffff0000u) + __uint_as_float(z.y & 0xffff0000u) * h0[3]);
        o.z = cvt_pk_bf16(__uint_as_float(y.z << 16) + __uint_as_float(z.z << 16) * h1[0], __uint_as_float(y.z & 0xffff0000u) + __uint_as_float(z.z & 0xffff0000u) * h1[1]);
        o.w = cvt_pk_bf16(__uint_as_float(y.w << 16) + __uint_as_float(z.w << 16) * h1[2], __uint_as_float(y.w & 0xffff0000u) + __uint_as_float(z.w & 0xffff0000u) * h1[3]);
        *(u32x4*)yp = o; }
}

#define XB_TMO      128
#define XB_XCNT(j)  (256  + 64 * (j))
#define XB_XSUB(j)  (1280 + 64 * (j))
#define XB_XGEN(j)  (2304 + 64 * (j))
#define XB_TOP      3328
#define XB_TOPGEN   3392
#define XCD_BAR_WORDS 3456
#define XB_SPIN_CAP (1u << 18)
__device__ __forceinline__ unsigned xb_ld(unsigned* p)              { return __hip_atomic_load(p, __ATOMIC_RELAXED, __HIP_MEMORY_SCOPE_AGENT); }
__device__ __forceinline__ unsigned xb_add(unsigned* p, unsigned v) { return __hip_atomic_fetch_add(p, v, __ATOMIC_RELAXED, __HIP_MEMORY_SCOPE_AGENT); }
__device__ __forceinline__ unsigned xb_xcc_id() { return (unsigned)__builtin_amdgcn_s_getreg((3 << 11) | 20) & 0xFu; }
#define XB_SPIN(cond, bar) do { unsigned _sp = 0; while (cond) { __builtin_amdgcn_s_sleep(1); \
    if ((++_sp & 255u) == 0u) { if (xb_ld(&(bar)[XB_TMO])) break; if (_sp > XB_SPIN_CAP) { atomicAdd(&(bar)[XB_TMO], 1u); break; } } } } while (0)
struct XcdBarrier { unsigned* bar; unsigned x; volatile LAS unsigned* st; };
__device__ __forceinline__ XcdBarrier xcd_barrier_post(unsigned* bar, volatile LAS unsigned* st) {
    XcdBarrier b; b.bar = bar; b.x = xb_xcc_id(); b.st = st;
    if (threadIdx.x == 0) (void)xb_add(&bar[XB_XCNT(b.x)], 1u);
    return b;
}
__device__ __forceinline__ void xcd_barrier_complete(unsigned* bar, unsigned x, unsigned& nloc, unsigned& nx) {
    const unsigned G = gridDim.x * gridDim.y * gridDim.z;
    unsigned sum, cnt, mine, sp = 0u;
    for (;;) {
        sum = 0u; cnt = 0u; mine = 0u;
#pragma unroll
        for (unsigned j = 0; j < 16; ++j) { const unsigned c = xb_ld(&bar[XB_XCNT(j)]); sum += c; cnt += (c > 0u) ? 1u : 0u; mine = (j == x) ? c : mine; }
        if (sum == G) break;
        __builtin_amdgcn_s_sleep(1);
        if ((++sp & 255u) == 0u) { if (xb_ld(&bar[XB_TMO])) break; if (sp > XB_SPIN_CAP) { atomicAdd(&bar[XB_TMO], 1u); break; } }
    }
    nloc = mine > 0u ? mine : 1u; nx = cnt > 0u ? cnt : 1u;
}
__device__ __forceinline__ void xcd_barrier(const XcdBarrier& b) {
    asm volatile("s_waitcnt vmcnt(0)" ::: "memory");
    __syncthreads();
    if (threadIdx.x == 0) {
        unsigned* bar = b.bar;
        __builtin_amdgcn_s_waitcnt(0);
        unsigned nloc = b.st[0], nx = b.st[1];
        if (nloc == 0u) { xcd_barrier_complete(bar, b.x, nloc, nx); b.st[0] = nloc; b.st[1] = nx; }
        const unsigned old = xb_add(&bar[XB_XSUB(b.x)], 1u);
        const unsigned gen = old / nloc;
        if (old + 1u == (gen + 1u) * nloc) {
            __builtin_amdgcn_fence(__ATOMIC_RELEASE, "agent");
            asm volatile("s_waitcnt vmcnt(0)" ::: "memory");
            const unsigned og = xb_add(&bar[XB_TOP], 1u);
            const unsigned tg = og / nx;
            if (og + 1u == (tg + 1u) * nx) xb_add(&bar[XB_TOPGEN], 1u);
            else XB_SPIN(xb_ld(&bar[XB_TOPGEN]) == tg, bar);
            __builtin_amdgcn_fence(__ATOMIC_ACQUIRE, "agent");
            xb_add(&bar[XB_XGEN(b.x)], 1u);
            asm volatile("s_waitcnt vmcnt(0)" ::: "memory");
        } else {
            XB_SPIN(xb_ld(&bar[XB_XGEN(b.x)]) == gen, bar);
            __builtin_amdgcn_fence(__ATOMIC_ACQUIRE, "agent");
            asm volatile("s_waitcnt vmcnt(0)" ::: "memory");
        }
    }
    __syncthreads();
}

#define GRID_SYNC() do { asm volatile("s_waitcnt vmcnt(0) lgkmcnt(0)" ::: "memory"); __syncthreads(); grid.sync(); asm volatile("" ::: "memory"); } while (0)
__device__ __forceinline__ int next_unit(unsigned* ctr, LAS unsigned char* lds) {
    LAS int* slot = (LAS int*)(lds + LDS_BYTES - 16);
    if (threadIdx.x == 0) *slot = (int)__hip_atomic_fetch_add(ctr, 1u, __ATOMIC_RELAXED, __HIP_MEMORY_SCOPE_AGENT);
    LDS_BAR();
    const int u = *slot;
    LDS_BAR();
    return __builtin_amdgcn_readfirstlane(u);
}
constexpr int N_CHAIN_BLOCKS = 56;
constexpr int GATES_EARLY = 24;
__global__ void __launch_bounds__(512) mega(Params p) {
    extern __shared__ __attribute__((aligned(16))) unsigned char smem[];
    LAS unsigned char* lds = (LAS unsigned char*)smem;
    cg::grid_group grid = cg::this_grid();
    const int G = gridDim.x;
    unsigned char* ws = p.ws;
    bf16_t* proj = (bf16_t*)(ws + WS_PROJ); bf16_t* gates = (bf16_t*)(ws + WS_GATES); bf16_t* hb = (bf16_t*)(ws + WS_HB);
    bf16_t* part = (bf16_t*)(ws + WS_PART); float* rstd = (float*)(ws + WS_RSTD);
    float* escA = (float*)(ws + WS_ESCA); float* escB = (float*)(ws + WS_ESCB); float* car = (float*)(ws + WS_CAR); float* hin = (float*)(ws + WS_HIN);

    volatile LAS unsigned* xst = (volatile LAS unsigned*)(lds + LDS_BYTES - 32);
    if (threadIdx.x == 0) { xst[0] = 0u; xst[1] = 0u; }
    if (blockIdx.x == 0) { unsigned* ctl = (unsigned*)(ws + WS_CTL);
        for (int i = threadIdx.x; i < (4096 + 16384) / 4; i += 512) __hip_atomic_store(ctl + i, 0u, __ATOMIC_RELAXED, __HIP_MEMORY_SCOPE_AGENT); }
    __syncthreads();
    prologue_phase(p, lds, G);
    pre_phase(p.in[0], (bf16_t*)(ws + WS_HB), (float*)(ws + WS_RSTD), G);
    GRID_SYNC();
    const XcdBarrier xbar = xcd_barrier_post((unsigned*)(ws + WS_BAR), xst);
#undef GRID_SYNC
#define GRID_SYNC() xcd_barrier(xbar)
    for (int layer = 0; layer < 2; ++layer) {
        const bf16_t* W1t = (const bf16_t*)(ws + WS_W1T) + (size_t)layer * NG1 * 1024;
        const bf16_t* Wmg = (const bf16_t*)(ws + WS_WMG) + (size_t)layer * 4096 * 1024;
        const bf16_t* Wb = (const bf16_t*)(ws + WS_WB) + (size_t)layer * 1024 * 2048;
        const bf16_t* Wo = (const bf16_t*)(ws + WS_WO) + (size_t)layer * 1024 * 1024;
        for (int half = 0; half < 2; ++half) {
            const int bid = opaque_s((int)blockIdx.x);
            const float* hsrc = (layer == 0 ? p.in[0] : p.out) + (size_t)half * TH * 1024;
            float* hdst = p.out + (size_t)half * TH * 1024;
            if (layer | half) { pre_phase(hsrc, hb, rstd, G); GRID_SYNC(); }
            { gm::InProjOrder S{(const char*)hb, (const char*)W1t, (const char*)Wmg, (size_t)256 * 1024 * 2, (size_t)256 * 1024 * 2, GATES_EARLY, G, bid};
              gm::EpiInProj E{{proj, NP, rstd}, {gates, 4096, rstd}};
              gm::gemm_phase(lds, S, E, 1024, 1024, 1024); }
            GRID_SYNC();
            { unsigned* ctr = (unsigned*)(ws + WS_CTL) + (layer * 2 + half) * 32;
              for (;;) { const int u = next_unit(ctr, lds); if (u >= 896) break;
                if (u < 128) sg_unit(lds, proj, u * 128, p.in[8] + layer * 512, p.in[9] + layer * 512, p.in[10] + (size_t)layer * 4 * 128 * 128, p.in[11] + layer * 4 * 128);
                else if (u < 384) { const int v = u - 128; const int bl = v >> 6;
                    lru_prep(lds, proj, bl, (v >> 4) & 3, (v & 15) * PREP_NCH, p.in[12] + layer * 4 * 512, p.in[13] + layer * 512, p.in[14] + (size_t)layer * 4 * 128 * 128, p.in[15] + layer * 512,
                             p.in[16] + (size_t)layer * 4 * 128 * 128, p.in[17] + layer * 512, p.in[18] + layer * 512, car + (size_t)bl * 64 * 512 * 2); }
                else if (u < 640) { const int v = u - 384; const int bh = v >> 4, c0 = (v & 15) * PREP_NCH; prep_attn<128, false>(lds, proj, bh >> 2, bh & 3, c0, layer, p.in[3], nullptr, escA + (size_t)(bh * 64 + c0) * 3 * 128); }
                else { const int v = u - 640; const int bh = v >> 4, c0 = (v & 15) * PREP_NCH; prep_attn<64, true>(lds, proj, bh >> 2, bh & 3, c0, layer, nullptr, p.in[6], escB + (size_t)(bh * 64 + c0) * 3 * 64); } } }
            GRID_SYNC();
            if (bid < 32) chain_hg_half(lds, proj, bid >> 3, (bid >> 1) & 3, escA + (size_t)(bid >> 1) * 64 * 3 * 128, (bid & 1) * 64);
            else if (bid < 48) chain_attn<64, true>(lds, proj, (bid - 32) >> 2, (bid - 32) & 3, escB + (size_t)(bid - 32) * 64 * 3 * 64, 0, 8);
            else if (bid < 52) lru_scan(car + (size_t)(bid - 48) * 64 * 512 * 2, hin + (size_t)(bid - 48) * 64 * 512);
            else if (bid >= N_CHAIN_BLOCKS) { gm::StaticOrder S; S.init(hb, Wmg, 1024, 1024, TH, 4096, G - N_CHAIN_BLOCKS, bid - N_CHAIN_BLOCKS, 1024 - GATES_EARLY);
              gm::EpiRowScaleBf16<1> E{gates, 4096, rstd};
              gm::gemm_phase(lds, S, E, 1024, 1024, 1024); }
            GRID_SYNC();
            for (int u = bid; u < 2560; u += G) {
                if (u >= 2304) { sg_post(proj, (u - 2304) * 64); continue; }
                if (u < 1024) { const int bh = u >> 6; post_attn(lds, proj, bh >> 2, bh & 3, u & 63, false, p.in[4] + layer * 128); }
                else if (u < 2048) { const int v = u - 1024; const int bh = v >> 6; post_attn(lds, proj, bh >> 2, bh & 3, v & 63, true, p.in[7] + layer * 128); }
                else { const int v = u - 2048; lru_post(proj, v >> 6, v & 63, hin + (size_t)(v >> 6) * 64 * 512); } }
            GRID_SYNC();
            { gm::BranchOrder S{(const char*)proj, (const char*)Wb, (size_t)256 * NP * 2, (size_t)256 * 2048 * 2, G, bid};
              gm::EpiBranch E{gates, part, proj + C_MERGED, NP};
              gm::gemm_phase(lds, S, E, 512, NP, 2048); }
            GRID_SYNC();
            { gm::StaticOrder S; S.init(proj + C_MERGED, Wo, NP, 1024, TH, 1024, G, bid);
              gm::EpiResidual E{hsrc, hdst};
              gm::gemm_phase(lds, S, E, 1024, NP, 1024); }
            GRID_SYNC();
        }
    }
    final_phase(p.out, p.in[21], G);
}

extern "C" void kernel_launch(void* const* d_in, const int* in_sizes, int n_in, void* d_out, int out_size, void* d_ws, size_t ws_size, hipStream_t stream) {
    static int grid_blocks = 0;
    if (!grid_blocks) {
        if (n_in != 22 || ws_size < WS_END) { fprintf(stderr, "kernel_launch: need 22 inputs and %zu ws bytes (got %d, %zu)\n", (size_t)WS_END, n_in, ws_size); grid_blocks = -1; return; }
        int dev = 0, cus = 0, per_cu = 0;
        hipGetDevice(&dev);
        hipDeviceGetAttribute(&cus, hipDeviceAttributeMultiprocessorCount, dev);
        if (hipFuncSetAttribute((const void*)mega, hipFuncAttributeMaxDynamicSharedMemorySize, LDS_BYTES) != hipSuccess) { fprintf(stderr, "kernel_launch: hipFuncSetAttribute failed\n"); grid_blocks = -1; return; }
        if (hipOccupancyMaxActiveBlocksPerMultiprocessor(&per_cu, (const void*)mega, 512, LDS_BYTES) != hipSuccess || per_cu < 1) { fprintf(stderr, "kernel_launch: occupancy query gave %d\n", per_cu); grid_blocks = -1; return; }
        grid_blocks = cus * per_cu;
        if (grid_blocks < 64) { fprintf(stderr, "kernel_launch: grid %d too small\n", grid_blocks); grid_blocks = -1; return; }
    }
    if (grid_blocks < 0) return;
    Params p{};
    for (int i = 0; i < 22; ++i) p.in[i] = (const float*)d_in[i];
    p.out = (float*)d_out; p.ws = (unsigned char*)d_ws;
    void* args[] = {&p};
    hipError_t e = hipLaunchCooperativeKernel((const void*)mega, dim3(grid_blocks), dim3(512), args, LDS_BYTES, stream);
    if (e != hipSuccess) fprintf(stderr, "cooperative launch failed: %s (grid %d)\n", hipGetErrorString(e), grid_blocks);
}
```

```cpp
#include <hip/hip_runtime.h>
#include <hip/hip_cooperative_groups.h>
#include <cstdio>
#include <cstdint>
namespace cg = cooperative_groups;

#define LAS __attribute__((address_space(3)))
typedef unsigned short bf16_t;
typedef short bf16x8 __attribute__((ext_vector_type(8)));
typedef float f32x4 __attribute__((ext_vector_type(4)));
typedef unsigned u32x4 __attribute__((ext_vector_type(4)));
typedef unsigned u32x2 __attribute__((ext_vector_type(2)));

constexpr int DM = 1024, SEQ = 4096, NTOK = 32768, TH = 16384  , NIN = 10256;
constexpr int NP = 7168, NG1 = 6400;
constexpr int C_HG = 0, C_GG = 512, C_SGT = 1024, C_RG = 1536;
constexpr int C_HQ = 2048, C_HF = 2560, C_HI = 3072, C_GQ = 3584, C_GK = 3840, C_GV = 4096, C_GKL = 4608, C_SU = 4864, C_SV = 5376, C_RX = 5888;
constexpr int C_PA = 6400  , C_Z = 6656  ;
constexpr int C_MERGED = 2048;
constexpr int LDS_BYTES = 147456;
constexpr float NORM_EPS = 1e-6f;

constexpr size_t WS_PROJ = 0;
constexpr size_t WS_GATES = WS_PROJ + (size_t)TH * NP * 2;
constexpr size_t WS_W1T = WS_GATES + (size_t)TH * 4096 * 2;
constexpr size_t WS_WMG = WS_W1T + (size_t)2 * NG1 * 1024 * 2;
constexpr size_t WS_WB = WS_WMG + (size_t)2 * 4096 * 1024 * 2;
constexpr size_t WS_WO = WS_WB + (size_t)2 * 1024 * 2048 * 2;
constexpr size_t WS_HB = WS_WO + (size_t)2 * 1024 * 1024 * 2;
constexpr size_t WS_PART = WS_HB + (size_t)TH * 1024 * 2;
constexpr size_t WS_RSTD = WS_PART + (size_t)TH * 1024 * 4;
constexpr size_t WS_ESCA = WS_RSTD + (size_t)TH * 20 * 4;
constexpr size_t WS_ESCB = WS_ESCA + (size_t)16 * 64 * 3 * 128 * 4;
constexpr size_t WS_CAR = WS_ESCB + (size_t)16 * 64 * 3 * 64 * 4;
constexpr size_t WS_HIN = WS_CAR + (size_t)4 * 64 * 512 * 2 * 4;
constexpr size_t WS_CTL = WS_HIN + (size_t)4 * 64 * 512 * 4;
constexpr size_t WS_BAR = WS_CTL + 4096;
constexpr size_t WS_END = WS_BAR + 16384;

struct Params { const float* in[22]; float* out; unsigned char* ws; };

__device__ __forceinline__ float bf2f(bf16_t b) { return __uint_as_float(((unsigned)b) << 16); }
typedef __bf16 bf16n2 __attribute__((ext_vector_type(2)));
typedef float f32x2 __attribute__((ext_vector_type(2)));
__device__ __forceinline__ unsigned cvt_pk_bf16(float lo, float hi) { const f32x2 v = {lo, hi}; const bf16n2 b = __builtin_convertvector(v, bf16n2); unsigned r; __builtin_memcpy(&r, &b, 4); return r; }
__device__ __forceinline__ bf16_t f2bf(float f) { return (bf16_t)(cvt_pk_bf16(f, 0.f) & 0xffffu); }
__device__ __forceinline__ float sigm(float x) { return __builtin_amdgcn_rcpf(1.0f + __expf(-x)); }
__device__ __forceinline__ float silu(float x) { return x * sigm(x); }
__device__ __forceinline__ float gelu_erf(float v) {
    const float av = fabsf(v), t = __builtin_amdgcn_rcpf(av * 0.2316418882f + 1.0f);
    float q = t * 0.5307027145f + (-0.7265760135f); q = q * t + 0.7107068705f; q = q * t + (-0.142248368f); q = q * t + 0.127414796f; q = q * t;
    const float e = __builtin_amdgcn_exp2f((v * v) * (-0.72134752044f));
    const float m = v * (q * e);
    return v < 0.f ? m : v - m;
}
__device__ __forceinline__ float wave_sum(float v) {
#pragma unroll
    for (int o = 32; o >= 1; o >>= 1) v += __shfl_xor(v, o);
    return v;
}
__device__ __forceinline__ int opaque_tid() { int t = threadIdx.x; asm volatile("" : "+v"(t)); return t; }
__device__ __forceinline__ int opaque_s(int v) { asm volatile("" : "+s"(v)); return v; }

namespace gm {
constexpr int BM = 256, BK = 64, HALF = 128, HTB = HALF * BK * 2, STAGE_BYTES = 8 * HTB, NXCD = 8, WGM = 8;
__device__ __forceinline__ int lds_byte(int r, int c) { const int st = (r >> 4) * 2 + (c >> 5), rr = r & 15, cc = c & 31, ob = rr * 64 + cc * 2; return st * 1024 + (ob ^ (((ob >> 9) & 1) << 5)); }
__device__ __forceinline__ void stage_rc(int b, int& R, int& C) { const int st = b / 1024, sb = b % 1024, swz = sb ^ (((sb >> 9) & 1) << 5); R = (st >> 1) * 16 + swz / 64; C = (st & 1) * 32 + (swz % 64) / 2; }
__device__ __forceinline__ int perm32(int rho) { const int n = rho >> 4, i = rho & 15; return 8 * (i >> 2) + 4 * n + (i & 3); }

struct Unit { const char* A; const char* B; int pm, pn, aux; };

__device__ __forceinline__ void tile_map(int wgid, const int nM, const int nN, int& pm, int& pn) {
    const int nwg = nM * nN;
    { const int q = nwg / NXCD, r = nwg % NXCD, xcd = wgid % NXCD, off = wgid / NXCD; wgid = (xcd < r ? xcd * (q + 1) : r * (q + 1) + (xcd - r) * q) + off; }
    const int nig = WGM * nN, gid = wgid / nig, fm = gid * WGM, gsz = (nM - fm) < WGM ? (nM - fm) : WGM;
    pm = fm + ((wgid % nig) % gsz); pn = (wgid % nig) / gsz;
}
struct StaticOrder {
    const char* Abase; const char* Bbase; size_t tA, tB; int nM, nN, lim, G, c;
    __device__ void init(const void* A, const void* B, int lda, int ldb, int M, int N, int G_, int c_, int lim_ = -1) {
        Abase = (const char*)A; Bbase = (const char*)B; tA = (size_t)BM * lda * 2; tB = (size_t)BM * ldb * 2; nM = M / BM; nN = N / BM; lim = lim_ < 0 ? nM * nN : lim_; G = G_; c = c_; }
    __device__ bool next(int i, Unit& u) const {
        const long L = (long)i * G + c; if (L >= lim) return false;
        tile_map((int)L, nM, nN, u.pm, u.pn); u.aux = 0;
        u.A = Abase + (size_t)u.pm * tA; u.B = Bbase + (size_t)u.pn * tB; return true;
    }
};
struct InProjOrder {
    const char* Abase; const char* B0; const char* B1; size_t tA, tB; int nx, G, c;
    __device__ bool next(int i, Unit& u) const {
        const long L = (long)i * G + c;
        if (L < 1600) { tile_map((int)L, 64, 25, u.pm, u.pn); u.aux = 0; u.B = B0 + (size_t)u.pn * tB; }
        else if (L < 1600 + nx) { tile_map(1024 - nx + (int)(L - 1600), 64, 16, u.pm, u.pn); u.aux = 1; u.B = B1 + (size_t)u.pn * tB; }
        else return false;
        u.A = Abase + (size_t)u.pm * tA; return true;
    }
};
struct BranchOrder {
    const char* Abase; const char* Bbase; size_t tA, tB; int G, c;
    __device__ bool next(int i, Unit& u) const {
        const int tt = c + (i >> 2) * G; if (tt >= 256) return false;
        const int b = i & 3; u.pm = tt >> 2; u.pn = tt & 3; u.aux = b;
        u.A = Abase + (size_t)u.pm * tA + (size_t)b * 1024; u.B = Bbase + (size_t)u.pn * tB + (size_t)b * 1024; return true;
    }
};

template <int ACT> struct EpiRowScaleBf16 {
    static constexpr bool PERM = true, KEEP = false;
    bf16_t* O; int ldc; const float* rstd;
    __device__ __forceinline__ void operator()(const f32x4 (&acc)[2][2][4][2], const Unit& u, int wr, int wc, int fr, int fq) const {
        const int row0 = u.pm * BM + wr * 64 + fr, col0 = u.pn * BM + wc * 32 + 8 * fq;
        float rs[2][4];
#pragma unroll
        for (int ai = 0; ai < 2; ++ai)
#pragma unroll
            for (int m = 0; m < 4; ++m) rs[ai][m] = rstd[row0 + ai * HALF + m * 16];
#pragma unroll
        for (int ai = 0; ai < 2; ++ai)
#pragma unroll
            for (int m = 0; m < 4; ++m) { const int row = row0 + ai * HALF + m * 16; bf16_t* rowp = O + (size_t)row * ldc + col0;
#pragma unroll
                for (int bj = 0; bj < 2; ++bj) { f32x4 v0 = acc[ai][bj][m][0] * rs[ai][m], v1 = acc[ai][bj][m][1] * rs[ai][m];
                    if (ACT == 1) {
#pragma unroll
                        for (int j = 0; j < 4; ++j) { v0[j] = sigm(v0[j]); v1[j] = sigm(v1[j]); } }
                    u32x4 w; w.x = cvt_pk_bf16(v0[0], v0[1]); w.y = cvt_pk_bf16(v0[2], v0[3]); w.z = cvt_pk_bf16(v1[0], v1[1]); w.w = cvt_pk_bf16(v1[2], v1[3]);
                    *(u32x4*)(rowp + bj * HALF) = w; } }
    }
};
struct EpiGateU8 {
    static constexpr bool PERM = true, KEEP = false;
    unsigned char* O; int ldc; const float* rstd;
    __device__ __forceinline__ void operator()(const f32x4 (&acc)[2][2][4][2], const Unit& u, int wr, int wc, int fr, int fq) const {
        const int row0 = u.pm * BM + wr * 64 + fr, col0 = u.pn * BM + wc * 32 + 8 * fq;
        float rs[2][4];
#pragma unroll
        for (int ai = 0; ai < 2; ++ai)
#pragma unroll
            for (int m = 0; m < 4; ++m) rs[ai][m] = rstd[row0 + ai * HALF + m * 16];
#pragma unroll
        for (int ai = 0; ai < 2; ++ai)
#pragma unroll
            for (int m = 0; m < 4; ++m) { const int row = row0 + ai * HALF + m * 16; unsigned char* rowp = O + (size_t)row * ldc + col0;
#pragma unroll
                for (int bj = 0; bj < 2; ++bj) { unsigned q[8];
#pragma unroll
                    for (int j = 0; j < 4; ++j) { q[j] = (unsigned)fmaxf(sigm(acc[ai][bj][m][0][j] * rs[ai][m]) * 255.0f + 0.5f, 1.0f); q[4 + j] = (unsigned)fmaxf(sigm(acc[ai][bj][m][1][j] * rs[ai][m]) * 255.0f + 0.5f, 1.0f); }
                    u32x2 w; w.x = q[0] | (q[1] << 8) | (q[2] << 16) | (q[3] << 24); w.y = q[4] | (q[5] << 8) | (q[6] << 16) | (q[7] << 24);
                    *(u32x2*)(rowp + bj * HALF) = w; } }
    }
};
struct EpiInProj {
    static constexpr bool PERM = true, KEEP = false;
    EpiRowScaleBf16<0> e0; EpiGateU8 e1;
    __device__ __forceinline__ void operator()(const f32x4 (&acc)[2][2][4][2], const Unit& u, int wr, int wc, int fr, int fq) const {
        if (u.aux) e1(acc, u, wr, wc, fr, fq); else e0(acc, u, wr, wc, fr, fq); }
};
__device__ __forceinline__ void unpack_u8(const u32x2 gg, f32x4& g0, f32x4& g1) { const float k255 = 1.0f / 255.0f;
    g0[0] = (float)(gg.x & 0xffu) * k255; g0[1] = (float)((gg.x >> 8) & 0xffu) * k255; g0[2] = (float)((gg.x >> 16) & 0xffu) * k255; g0[3] = (float)(gg.x >> 24) * k255;
    g1[0] = (float)(gg.y & 0xffu) * k255; g1[1] = (float)((gg.y >> 8) & 0xffu) * k255; g1[2] = (float)((gg.y >> 16) & 0xffu) * k255; g1[3] = (float)(gg.y >> 24) * k255; }
struct EpiBranch {
    static constexpr bool PERM = true, KEEP = true;
    const unsigned char* gates; bf16_t* part; bf16_t* merged; int ldm;
    __device__ __forceinline__ void operator()(f32x4 (&acc)[2][2][4][2], const Unit& u, int wr, int wc, int fr, int fq) const {
        const int row0 = u.pm * BM + wr * 64 + fr, col0 = u.pn * BM + wc * 32 + 8 * fq; const int b = u.aux;
        if ((b & 1) == 0) {
#pragma unroll
            for (int ai = 0; ai < 2; ++ai) { u32x2 ga[4][2], gb[4][2];
#pragma unroll
                for (int m = 0; m < 4; ++m) { const unsigned char* gp = gates + (size_t)(row0 + ai * HALF + m * 16) * 4096 + b * 1024 + col0;
#pragma unroll
                    for (int bj = 0; bj < 2; ++bj) { ga[m][bj] = *(const u32x2*)(gp + bj * HALF); gb[m][bj] = *(const u32x2*)(gp + 1024 + bj * HALF); } }
#pragma unroll
                for (int m = 0; m < 4; ++m)
#pragma unroll
                    for (int bj = 0; bj < 2; ++bj) { f32x4 a0, a1, b0, b1; unpack_u8(ga[m][bj], a0, a1); unpack_u8(gb[m][bj], b0, b1);
#pragma unroll
                        for (int j = 0; j < 4; ++j) { acc[ai][bj][m][0][j] *= a0[j] * __builtin_amdgcn_rcpf(b0[j]); acc[ai][bj][m][1][j] *= a1[j] * __builtin_amdgcn_rcpf(b1[j]); } }
                asm volatile("" ::: "memory"); }
        } else {
#pragma unroll
            for (int ai = 0; ai < 2; ++ai) { u32x2 g[4][2]; u32x4 pv[4][2];
#pragma unroll
                for (int m = 0; m < 4; ++m) { const int row = row0 + ai * HALF + m * 16;
#pragma unroll
                    for (int bj = 0; bj < 2; ++bj) { g[m][bj] = *(const u32x2*)(gates + (size_t)row * 4096 + b * 1024 + col0 + bj * HALF);
                        if (b == 3) pv[m][bj] = *(const u32x4*)(part + (size_t)row * 1024 + col0 + bj * HALF); } }
#pragma unroll
                for (int m = 0; m < 4; ++m) { const int row = row0 + ai * HALF + m * 16;
#pragma unroll
                    for (int bj = 0; bj < 2; ++bj) { f32x4 g0, g1; unpack_u8(g[m][bj], g0, g1);
                        f32x4 v0 = acc[ai][bj][m][0] * g0, v1 = acc[ai][bj][m][1] * g1;
                        if (b == 3) { const u32x4 pp = pv[m][bj];
                            v0[0] += __uint_as_float(pp.x << 16); v0[1] += __uint_as_float(pp.x & 0xffff0000u); v0[2] += __uint_as_float(pp.y << 16); v0[3] += __uint_as_float(pp.y & 0xffff0000u);
                            v1[0] += __uint_as_float(pp.z << 16); v1[1] += __uint_as_float(pp.z & 0xffff0000u); v1[2] += __uint_as_float(pp.w << 16); v1[3] += __uint_as_float(pp.w & 0xffff0000u); }
                        u32x4 w; w.x = cvt_pk_bf16(v0[0], v0[1]); w.y = cvt_pk_bf16(v0[2], v0[3]); w.z = cvt_pk_bf16(v1[0], v1[1]); w.w = cvt_pk_bf16(v1[2], v1[3]);
                        if (b == 1) *(u32x4*)(part + (size_t)row * 1024 + col0 + bj * HALF) = w;
                        else *(u32x4*)(merged + (size_t)row * ldm + col0 + bj * HALF) = w; } }
                asm volatile("" ::: "memory"); }
        }
    }
};
struct EpiResidToBf16 {
    static constexpr bool PERM = false, KEEP = false;
    const float* src; bf16_t* hbn; float* ssq;
    __device__ __forceinline__ void operator()(const f32x4 (&acc)[2][2][4][2], const Unit& u, int wr, int wc, int fr, int fq) const {
        const int row0 = u.pm * BM + wr * 64 + fr, col0 = u.pn * BM + wc * 32 + 4 * fq;
#pragma unroll
        for (int ai = 0; ai < 2; ++ai) {
            f32x4 sv[4][2][2];
#pragma unroll
            for (int m = 0; m < 4; ++m) { const size_t off = (size_t)(row0 + ai * HALF + m * 16) * 1024 + col0;
#pragma unroll
                for (int bj = 0; bj < 2; ++bj)
#pragma unroll
                    for (int n = 0; n < 2; ++n) sv[m][bj][n] = *(const f32x4*)(src + off + bj * HALF + n * 16); }
#pragma unroll
            for (int m = 0; m < 4; ++m) { const int row = row0 + ai * HALF + m * 16; const size_t off = (size_t)row * 1024 + col0; float q = 0.f;
#pragma unroll
                for (int bj = 0; bj < 2; ++bj)
#pragma unroll
                    for (int n = 0; n < 2; ++n) { const f32x4 o = sv[m][bj][n] + acc[ai][bj][m][n];
                        u32x2 w; w.x = cvt_pk_bf16(o[0], o[1]); w.y = cvt_pk_bf16(o[2], o[3]); *(u32x2*)(hbn + off + bj * HALF + n * 16) = w;
                        const float r0 = __uint_as_float(w.x << 16), r1 = __uint_as_float(w.x & 0xffff0000u), r2 = __uint_as_float(w.y << 16), r3 = __uint_as_float(w.y & 0xffff0000u);
                        q += (r0 * r0 + r1 * r1) + (r2 * r2 + r3 * r3); }
                q += __shfl_xor(q, 16); q += __shfl_xor(q, 32);
                if (fq == 0) ssq[((size_t)u.pn * TH + row) * 4 + wc] = q; }
            asm volatile("" ::: "memory"); }
    }
};
struct EpiResidFromBf16 {
    static constexpr bool PERM = false, KEEP = false;
    const bf16_t* src; float* dst;
    __device__ __forceinline__ void operator()(const f32x4 (&acc)[2][2][4][2], const Unit& u, int wr, int wc, int fr, int fq) const {
        const int row0 = u.pm * BM + wr * 64 + fr, col0 = u.pn * BM + wc * 32 + 4 * fq;
#pragma unroll
        for (int ai = 0; ai < 2; ++ai) {
            u32x2 sv[4][2][2];
#pragma unroll
            for (int m = 0; m < 4; ++m) { const size_t off = (size_t)(row0 + ai * HALF + m * 16) * 1024 + col0;
#pragma unroll
                for (int bj = 0; bj < 2; ++bj)
#pragma unroll
                    for (int n = 0; n < 2; ++n) sv[m][bj][n] = *(const u32x2*)(src + off + bj * HALF + n * 16); }
#pragma unroll
            for (int m = 0; m < 4; ++m) { const size_t off = (size_t)(row0 + ai * HALF + m * 16) * 1024 + col0;
#pragma unroll
                for (int bj = 0; bj < 2; ++bj)
#pragma unroll
                    for (int n = 0; n < 2; ++n) { const u32x2 w = sv[m][bj][n]; f32x4 r;
                        r[0] = __uint_as_float(w.x << 16); r[1] = __uint_as_float(w.x & 0xffff0000u); r[2] = __uint_as_float(w.y << 16); r[3] = __uint_as_float(w.y & 0xffff0000u);
                        const f32x4 o = r + acc[ai][bj][m][n]; u32x2 ow; ow.x = cvt_pk_bf16(o[0], o[1]); ow.y = cvt_pk_bf16(o[2], o[3]);
                        *(u32x2*)((bf16_t*)dst + 2 * (size_t)(row0 + ai * HALF + m * 16) * 1024 + col0 + bj * HALF + n * 16) = ow; } }
            asm volatile("" ::: "memory"); }
    }
};

template <class Epi, class Sched>
__device__ __forceinline__ void gemm_phase(LAS unsigned char* lds, const Sched& S, const Epi& E, const int K, const int lda, const int ldb) {
    const int tid = opaque_tid(), wid = __builtin_amdgcn_readfirstlane(tid >> 6), lane = tid & 63, wr = wid >> 2, wc = wid & 3, fr = lane & 15, fq = lane >> 4;
    const int nt = K / BK;
    unsigned voffA[2], voffB[2];
#pragma unroll
    for (int i = 0; i < 2; ++i) { int R, C; stage_rc(tid * 16 + i * 8192, R, C); const int Rb = Epi::PERM ? ((R & ~31) + perm32(R & 31)) : R;
        voffA[i] = (unsigned)(R * lda + C) * 2u; voffB[i] = (unsigned)(Rb * ldb + C) * 2u; }
    const size_t kstep = (size_t)(BK * 2);
    const size_t hstepA = (size_t)HALF * lda * 2, hstepB = (size_t)HALF * ldb * 2;
    const unsigned ldsw = (unsigned)wid * 1024u;
    const int aoff = lds_byte(wr * 64 + fr, fq * 8), boff = lds_byte(wc * 32 + fr, fq * 8);
#define PG8_SA(b, h) (((b) * 2 + (h)) * HTB)
#define PG8_SB(b, h) ((4 + (b) * 2 + (h)) * HTB)
#define PG8_STAGE(bufoff, gbase, voff) do { _Pragma("unroll") for (int _i = 0; _i < 2; ++_i) \
        __builtin_amdgcn_global_load_lds((const unsigned*)((const char*)(gbase) + (voff)[_i]), (LAS unsigned*)(lds + (bufoff) + ldsw + _i * 8192), 16, 0, 0); } while (0)
#define PG8_LDA(dst, b, h) do { _Pragma("unroll") for (int m = 0; m < 4; ++m) _Pragma("unroll") for (int k = 0; k < 2; ++k) dst[m][k] = *(const LAS bf16x8*)(lds + PG8_SA(b, h) + aoff + m * 2048 + k * 1024); } while (0)
#define PG8_LDB(dst, b, h) do { _Pragma("unroll") for (int n = 0; n < 2; ++n) _Pragma("unroll") for (int k = 0; k < 2; ++k) dst[n][k] = *(const LAS bf16x8*)(lds + PG8_SB(b, h) + boff + n * 2048 + k * 1024); } while (0)
#define PG8_MMA(ai, bj, At, Bt) do { __builtin_amdgcn_s_setprio(1); _Pragma("unroll") for (int m = 0; m < 4; ++m) _Pragma("unroll") for (int n = 0; n < 2; ++n) _Pragma("unroll") for (int k = 0; k < 2; ++k) \
        acc[ai][bj][m][n] = __builtin_amdgcn_mfma_f32_16x16x32_bf16(Bt[n][k], At[m][k], acc[ai][bj][m][n], 0, 0, 0); __builtin_amdgcn_s_setprio(0); } while (0)
#define PG8_WAIT_V(n) asm volatile("s_waitcnt vmcnt(" #n ")" ::: "memory")
#define PG8_WAIT_L(n) asm volatile("s_waitcnt lgkmcnt(" #n ")" ::: "memory")
#define PG8_BAR __builtin_amdgcn_s_barrier()
#define PG8_SCHED __builtin_amdgcn_sched_barrier(0)
    Unit cur, nxt; int ui = 0;
    if (!S.next(0, cur)) return;
    f32x4 acc[2][2][4][2];
#pragma unroll
    for (int a = 0; a < 2; ++a)
#pragma unroll
        for (int b = 0; b < 2; ++b)
#pragma unroll
            for (int m = 0; m < 4; ++m)
#pragma unroll
                for (int n = 0; n < 2; ++n) acc[a][b][m][n] = (f32x4){0.f, 0.f, 0.f, 0.f};
    bf16x8 At[4][2], B0[2][2], B1[2][2];
    const char* cA = cur.A; const char* cB = cur.B;
    PG8_STAGE(PG8_SB(0, 0), cB, voffB); PG8_STAGE(PG8_SA(0, 0), cA, voffA); PG8_STAGE(PG8_SB(0, 1), cB + hstepB, voffB); PG8_STAGE(PG8_SA(0, 1), cA + hstepA, voffA);
    if (wr == 1) PG8_BAR;
    PG8_WAIT_V(4); PG8_BAR;
    PG8_STAGE(PG8_SB(1, 0), cB + kstep, voffB); PG8_STAGE(PG8_SA(1, 0), cA + kstep, voffA); PG8_STAGE(PG8_SB(1, 1), cB + hstepB + kstep, voffB);
    PG8_WAIT_V(6); PG8_BAR;
    for (;;) {
        const bool has_next = S.next(ui + 1, nxt);
        const char* nA = has_next ? nxt.A : cA; const char* nB = has_next ? nxt.B : cB;
        for (int t = 0; t < nt; t += 2) {
            const bool last = (t == nt - 2);
            const char* a1 = cA + (size_t)(t + 1) * kstep;
            const char* a2 = last ? nA : cA + (size_t)(t + 2) * kstep; const char* b2 = last ? nB : cB + (size_t)(t + 2) * kstep;
            const char* a3 = a2 + kstep; const char* b3 = b2 + kstep;
            PG8_LDB(B0, 0, 0); PG8_SCHED; PG8_LDA(At, 0, 0); PG8_STAGE(PG8_SA(1, 1), a1 + hstepA, voffA);
            PG8_WAIT_L(8); PG8_BAR; PG8_WAIT_L(0); PG8_MMA(0, 0, At, B0); PG8_BAR; PG8_SCHED;
            PG8_LDB(B1, 0, 1); PG8_STAGE(PG8_SB(0, 0), b2, voffB);
            PG8_BAR; PG8_WAIT_L(0); PG8_MMA(0, 1, At, B1); PG8_BAR;
            PG8_LDA(At, 0, 1); PG8_STAGE(PG8_SA(0, 0), a2, voffA);
            PG8_BAR; PG8_WAIT_L(0); PG8_MMA(1, 0, At, B0); PG8_BAR; PG8_SCHED;
            PG8_STAGE(PG8_SB(0, 1), b2 + hstepB, voffB);
            PG8_WAIT_V(6); PG8_BAR; PG8_MMA(1, 1, At, B1); PG8_BAR;
            PG8_LDB(B0, 1, 0); PG8_SCHED; PG8_LDA(At, 1, 0); PG8_STAGE(PG8_SA(0, 1), a2 + hstepA, voffA);
            PG8_WAIT_L(8); PG8_BAR; PG8_WAIT_L(0); PG8_MMA(0, 0, At, B0); PG8_BAR; PG8_SCHED;
            PG8_LDB(B1, 1, 1); PG8_STAGE(PG8_SB(1, 0), b3, voffB);
            PG8_BAR; PG8_WAIT_L(0); PG8_MMA(0, 1, At, B1); PG8_BAR;
            PG8_LDA(At, 1, 1); PG8_STAGE(PG8_SA(1, 0), a3, voffA);
            PG8_BAR; PG8_WAIT_L(0); PG8_MMA(1, 0, At, B0); PG8_BAR; PG8_SCHED;
            PG8_STAGE(PG8_SB(1, 1), b3 + hstepB, voffB);
            PG8_WAIT_V(6); PG8_BAR; PG8_MMA(1, 1, At, B1); PG8_BAR;
        }
        E(acc, cur, wr, wc, fr, fq);
        if (!has_next) break;
        bool keep = false;
        if constexpr (Epi::KEEP) keep = (cur.aux & 1) == 0;
        if (!keep) {
#pragma unroll
        for (int a = 0; a < 2; ++a)
#pragma unroll
            for (int b = 0; b < 2; ++b)
#pragma unroll
                for (int m = 0; m < 4; ++m)
#pragma unroll
                    for (int n = 0; n < 2; ++n) acc[a][b][m][n] = (f32x4){0.f, 0.f, 0.f, 0.f};
        }
        cur = nxt; cA = nA; cB = nB; ++ui;
    }
    PG8_WAIT_V(0);
    if (wr == 0) PG8_BAR;
    PG8_BAR;
#undef PG8_SA
#undef PG8_SB
#undef PG8_STAGE
#undef PG8_LDA
#undef PG8_LDB
#undef PG8_MMA
#undef PG8_WAIT_V
#undef PG8_WAIT_L
#undef PG8_BAR
#undef PG8_SCHED
}
}

#define LDS_BAR() do { asm volatile("s_waitcnt lgkmcnt(0)" ::: "memory"); __builtin_amdgcn_s_barrier(); asm volatile("" ::: "memory"); } while (0)
#define MFMA16(a, b, c) __builtin_amdgcn_mfma_f32_16x16x32_bf16((a), (b), (c), 0, 0, 0)

__device__ __forceinline__ int w1_src_col(int n0) {
    if (n0 < 512) return 1536 + n0;
    if (n0 < 1024) return 3072 + (n0 - 512);
    if (n0 < 1536) return 4624 + (n0 - 1024);
    if (n0 < 2048) return 5648 + (n0 - 1536);
    if (n0 < 2560) return 0 + (n0 - 2048);
    if (n0 < 3072) return 512 + (n0 - 2560);
    if (n0 < 3584) return 1024 + (n0 - 3072);
    if (n0 < 3840) return 2048 + (n0 - 3584);
    if (n0 < 4096) return 2304 + (n0 - 3840);
    if (n0 < 4608) return 2560 + (n0 - 4096);
    if (n0 < 4864) return -1;
    if (n0 < 5376) return 3600 + (n0 - 4864);
    if (n0 < 5888) return 4112 + (n0 - 5376);
    return 5136 + (n0 - 5888);
}
struct ProTile { const float* src; const float* scale; const float* gw; bf16_t* dst; int ldsrc, scol, n0, k0, ldd; };
__device__ __forceinline__ ProTile pro_tile(const Params& p, const int idx) {
    const float* norm_w = p.in[1]; const float* w_in = p.in[2]; const float* gk_w = p.in[5]; const float* w_branch = p.in[19]; const float* w_out = p.in[20];
    ProTile t; t.scale = nullptr; t.gw = nullptr;
    const int l = idx / 3392; int r = idx % 3392;
    if (r < 1600) { t.n0 = (r >> 4) * 64; t.k0 = (r & 15) * 64; t.src = w_in + (size_t)l * 1024 * NIN; t.ldsrc = NIN; t.scol = w1_src_col(t.n0); t.scale = norm_w + l * 1024;
        if (t.scol < 0) t.gw = gk_w + (size_t)l * 16 * 256 + (t.n0 - C_GKL);
        t.dst = (bf16_t*)(p.ws + WS_W1T) + (size_t)l * NG1 * 1024; t.ldd = 1024; }
    else if (r < 2624) { r -= 1600; t.n0 = (r >> 4) * 64; t.k0 = (r & 15) * 64; t.src = w_in + (size_t)l * 1024 * NIN; t.ldsrc = NIN; t.scol = 6160 + t.n0; t.scale = norm_w + l * 1024;
        t.dst = (bf16_t*)(p.ws + WS_WMG) + (size_t)l * 4096 * 1024; t.ldd = 1024; }
    else if (r < 3136) { r -= 2624; const int b = r >> 7; const int r2 = r & 127; t.n0 = (r2 >> 3) * 64; t.k0 = (r2 & 7) * 64; t.src = w_branch + (size_t)(l * 4 + b) * 512 * 1024; t.ldsrc = 1024; t.scol = t.n0;
        t.dst = (bf16_t*)(p.ws + WS_WB) + (size_t)l * 1024 * 2048 + b * 512; t.ldd = 2048; }
    else { r -= 3136; t.n0 = (r >> 4) * 64; t.k0 = (r & 15) * 64; t.src = w_out + (size_t)l * 1024 * 1024; t.ldsrc = 1024; t.scol = t.n0;
        t.dst = (bf16_t*)(p.ws + WS_WO) + (size_t)l * 1024 * 1024; t.ldd = 1024; }
    return t;
}
__device__ void prologue_phase(const Params& p, LAS unsigned char* lds, const int G) {
    constexpr int NT = 2 * 3392, GRP = 4;
    const int tid = opaque_tid();
    const int n = tid & 63, kq = tid >> 6, nn = tid >> 3, k8 = tid & 7;
    for (int base = blockIdx.x * GRP; base < NT; base += G * GRP) {
#pragma unroll
        for (int gi = 0; gi < GRP; ++gi) { if (base + gi >= NT) break; const int idx = (int)(((long)(base + gi) * 61) % NT);
            const ProTile t = pro_tile(p, idx); LAS float* tile = (LAS float*)(lds + gi * 16896);
#pragma unroll
            for (int e = 0; e < 8; ++e) { const int k = kq * 8 + e; float v;
                if (!t.gw) v = t.src[(size_t)(t.k0 + k) * t.ldsrc + t.scol + n];
                else { v = 0.f; const float* lr = t.src + (size_t)(t.k0 + k) * NIN + 3584;
                    for (int rr = 0; rr < 16; ++rr) v += lr[rr] * t.gw[rr * 256 + n]; }
                if (t.scale) v *= t.scale[t.k0 + k];
                tile[k * 65 + n] = v; } }
        LDS_BAR();
#pragma unroll
        for (int gi = 0; gi < GRP; ++gi) { if (base + gi >= NT) break; const int idx = (int)(((long)(base + gi) * 61) % NT);
            const ProTile t = pro_tile(p, idx); LAS float* tile = (LAS float*)(lds + gi * 16896); float v[8];
#pragma unroll
            for (int e = 0; e < 8; ++e) v[e] = tile[(k8 * 8 + e) * 65 + nn];
            u32x4 w; w.x = cvt_pk_bf16(v[0], v[1]); w.y = cvt_pk_bf16(v[2], v[3]); w.z = cvt_pk_bf16(v[4], v[5]); w.w = cvt_pk_bf16(v[6], v[7]);
            *(u32x4*)(t.dst + (size_t)(t.n0 + nn) * t.ldd + t.k0 + k8 * 8) = w; }
        LDS_BAR();
    }
}

__device__ void pre_phase(const float* hsrc, bf16_t* hb, float* rstd, const int G) {
    const int tid = opaque_tid(); const int lane = tid & 63, wv = tid >> 6;
    for (int rr = blockIdx.x * 32 + wv * 4; rr < TH; rr += G * 32)
    for (int r = rr; r < rr + 4; ++r) {
        const float* row = hsrc + (size_t)r * 1024; f32x4 v[4]; float ss = 0.f;
#pragma unroll
        for (int e = 0; e < 4; ++e) { v[e] = *(const f32x4*)(row + e * 256 + lane * 4); ss += v[e][0] * v[e][0] + v[e][1] * v[e][1] + v[e][2] * v[e][2] + v[e][3] * v[e][3]; }
        ss = wave_sum(ss);
        if (lane == 0) rstd[r] = rsqrtf(ss * (1.0f / 1024.0f) + NORM_EPS);
#pragma unroll
        for (int e = 0; e < 4; ++e) { u32x2 w; w.x = cvt_pk_bf16(v[e][0], v[e][1]); w.y = cvt_pk_bf16(v[e][2], v[e][3]); *(u32x2*)(hb + (size_t)r * 1024 + e * 256 + lane * 4) = w; }
    }
}
__device__ void final_phase(float* out, const float* w, const int G) {
    const int tid = opaque_tid(); const int lane = tid & 63, gw = blockIdx.x * 8 + (tid >> 6), nw = G * 8;
    f32x4 wv[4];
#pragma unroll
    for (int e = 0; e < 4; ++e) wv[e] = *(const f32x4*)(w + e * 256 + lane * 4);
    for (int r = gw; r < NTOK; r += nw) {
        float* row = out + (size_t)r * 1024; f32x4 v[4]; float ss = 0.f;
#pragma unroll
        for (int e = 0; e < 4; ++e) { const u32x2 hw = *(const u32x2*)((const bf16_t*)row + e * 256 + lane * 4);
            v[e][0] = __uint_as_float(hw.x << 16); v[e][1] = __uint_as_float(hw.x & 0xffff0000u); v[e][2] = __uint_as_float(hw.y << 16); v[e][3] = __uint_as_float(hw.y & 0xffff0000u);
            ss += v[e][0] * v[e][0] + v[e][1] * v[e][1] + v[e][2] * v[e][2] + v[e][3] * v[e][3]; }
        ss = wave_sum(ss);
        const float rs = rsqrtf(ss * (1.0f / 1024.0f) + NORM_EPS);
        asm volatile("s_waitcnt vmcnt(0)" ::: "memory");
#pragma unroll
        for (int e = 0; e < 4; ++e) *(f32x4*)(row + e * 256 + lane * 4) = v[e] * rs * wv[e];
    }
}

constexpr int CA_QT = 0, CA_KT = 17408, CA_CS = 34816;
constexpr int PREP_NCH = 4;
template <int DK, bool GLA>
__device__ void prep_attn(LAS unsigned char* lds, bf16_t* proj, const int bl, const int h, const int c, const int layer, const float* lb_logits, const float* gk_b, float* esc) {
    constexpr int NPQ = 512 / DK, PL = 64 / NPQ, QS = (DK + 8) * 2, KS = DK / 32;
    const int tid = opaque_tid(), lane = tid & 63, w = __builtin_amdgcn_readfirstlane(tid >> 6), fr = lane & 15, fq = lane >> 4;
    const int k = tid % DK, pq = tid / DK;
    const int vj = tid & 127, vq = tid >> 7;
    const int cq = GLA ? (C_GQ + h * 64) : (C_HQ + h * 128), cz = GLA ? (C_GKL + h * 64) : (C_HF + h * 128), ck = C_GK + h * 64;
    const int cv = (GLA ? C_GV : C_HI) + h * 128, cp = (GLA ? C_GKL : C_PA) + h * 64, ckt = GLA ? ck : cz;
    const float scale = GLA ? 0.125f : 0.08838834764831845f;
    float lb = 0.f, gbias = 0.f;
    if (GLA) gbias = gk_b[layer * 256 + h * 64 + k];
    else if (layer == 1) lb = sigm(lb_logits[512 + h * 128 + k] - lb_logits[h * 128 + k]);
    const float oml = 1.0f - lb;
    LAS float* cs = (LAS float*)(lds + CA_CS);
    bf16_t* tbase = proj + ((size_t)bl * SEQ + (size_t)c * 64) * NP;
    const unsigned eoff = (unsigned)(pq * PL) * NP + k, voff = (unsigned)(vq * 16) * NP + vj;
    bf16_t rq[PL], rz[PL], rk[PL], rv[16];
#pragma unroll
    for (int e = 0; e < PL; ++e) { const bf16_t* rp = tbase + e * NP; rq[e] = (rp + cq)[eoff]; rz[e] = (rp + cz)[eoff]; rk[e] = GLA ? (rp + ck)[eoff] : (bf16_t)0; }
#pragma unroll
    for (int e = 0; e < 16; ++e) rv[e] = (tbase + e * NP + cv)[voff];
  for (int cc = 0; cc < PREP_NCH; ++cc) {
    bf16_t* t0 = tbase + (size_t)cc * 64 * NP;
    float bl_[PL], kk[PL], qq[PL]; float run = 0.f;
#pragma unroll
    for (int e = 0; e < PL; ++e) { const float z = bf2f(rz[e]); float lf, key;
        if (GLA) { const float x = z + gbias; lf = (fminf(x, 0.f) - __logf(1.0f + __expf(-fabsf(x)))) * 0.0625f; key = bf2f(rk[e]); }
        else { const float sg = sigm(fmaxf(z, -80.f)); lf = __logf(lb + oml * sg); key = oml * (1.0f - sg); }
        run += lf; bl_[e] = run; kk[e] = key; qq[e] = bf2f(rq[e]) * scale; }
    cs[pq * DK + k] = run;
    u32x4 w0, w1; w0.x = rv[0] | ((unsigned)rv[1] << 16); w0.y = rv[2] | ((unsigned)rv[3] << 16); w0.z = rv[4] | ((unsigned)rv[5] << 16); w0.w = rv[6] | ((unsigned)rv[7] << 16);
    w1.x = rv[8] | ((unsigned)rv[9] << 16); w1.y = rv[10] | ((unsigned)rv[11] << 16); w1.z = rv[12] | ((unsigned)rv[13] << 16); w1.w = rv[14] | ((unsigned)rv[15] << 16);
    LDS_BAR();
    if (cc + 1 < PREP_NCH) { const bf16_t* t1 = t0 + (size_t)64 * NP;
#pragma unroll
        for (int e = 0; e < PL; ++e) { const bf16_t* rp = t1 + e * NP; rq[e] = (rp + cq)[eoff]; rz[e] = (rp + cz)[eoff]; rk[e] = GLA ? (rp + ck)[eoff] : (bf16_t)0; }
#pragma unroll
        for (int e = 0; e < 16; ++e) rv[e] = (t1 + e * NP + cv)[voff]; }
    { bf16_t* vp = t0 + (vj >> 1) * NP + cv + (vj & 1) * 64 + vq * 16; *(u32x4*)vp = w0; *(u32x4*)(vp + 8) = w1; }
    float prefix = 0.f, bm = 0.f, blast = 0.f;
#pragma unroll
    for (int q2 = 0; q2 < NPQ; ++q2) { const float v = cs[q2 * DK + k]; if (q2 < pq) prefix += v; if (q2 < NPQ / 2) bm += v; blast += v; }
    { const int kperm = 32 * (k >> 5) + 8 * ((k >> 2) & 3) + 4 * ((k >> 4) & 1) + (k & 3);
      const unsigned qoff = (unsigned)(pq * PL) * NP + kperm;
      unsigned ktp[PL / 2];
#pragma unroll
      for (int e = 0; e < PL; e += 2) {
          const float b0 = prefix + bl_[e], b1 = prefix + bl_[e + 1];
          const float q0 = qq[e] * __expf(fminf(b0 - bm, 80.f)), q1 = qq[e + 1] * __expf(fminf(b1 - bm, 80.f));
          const float k0 = kk[e] * __expf(fminf(bm - b0, 80.f)), k1 = kk[e + 1] * __expf(fminf(bm - b1, 80.f));
          const unsigned qp = cvt_pk_bf16(q0, q1), kp = cvt_pk_bf16(k0, k1);
          const int p0 = pq * PL + e;
          *(LAS bf16_t*)(lds + CA_QT + p0 * QS + k * 2) = (bf16_t)(qp & 0xffffu); *(LAS bf16_t*)(lds + CA_QT + (p0 + 1) * QS + k * 2) = (bf16_t)(qp >> 16);
          *(LAS bf16_t*)(lds + CA_KT + p0 * QS + k * 2) = (bf16_t)(kp & 0xffffu); *(LAS bf16_t*)(lds + CA_KT + (p0 + 1) * QS + k * 2) = (bf16_t)(kp >> 16);
          (t0 + e * NP + cq)[qoff] = (bf16_t)(qp & 0xffffu); (t0 + (e + 1) * NP + cq)[qoff] = (bf16_t)(qp >> 16);
          ktp[e / 2] = kp; }
      bf16_t* kp_ = GLA ? (t0 + k * NP + ckt + pq * PL) : (t0 + (k >> 1) * NP + ckt + (k & 1) * 64 + pq * PL);
#pragma unroll
      for (int e = 0; e < PL / 8; ++e) { u32x4 wv; wv.x = ktp[e * 4]; wv.y = ktp[e * 4 + 1]; wv.z = ktp[e * 4 + 2]; wv.w = ktp[e * 4 + 3]; *(u32x4*)(kp_ + e * 8) = wv; } }
    if (pq == 0) { float* ec = esc + (size_t)cc * 3 * DK; ec[k] = __expf(bm); ec[DK + k] = __expf(blast - bm); ec[2 * DK + k] = __expf(blast); }
    LDS_BAR();
    const unsigned poff = (unsigned)(4 * fq) * NP + fr;
#pragma unroll
    for (int rep = 0; rep < 2; ++rep) { const int id = w + rep * 8, it = id >> 2, jt = id & 3;
        f32x4 pa = (f32x4){0.f, 0.f, 0.f, 0.f};
        if (jt <= it) {
#pragma unroll
            for (int ks = 0; ks < KS; ++ks) { const bf16x8 a = *(const LAS bf16x8*)(lds + CA_QT + (it * 16 + fr) * QS + (ks * 32 + fq * 8) * 2);
                const bf16x8 b = *(const LAS bf16x8*)(lds + CA_KT + (jt * 16 + fr) * QS + (ks * 32 + fq * 8) * 2); pa = MFMA16(a, b, pa); }
            if (jt == it) {
#pragma unroll
                for (int jj = 0; jj < 4; ++jj) if (fr > 4 * fq + jj) pa[jj] = 0.f; } }
#pragma unroll
        for (int jj = 0; jj < 4; ++jj) (t0 + (it * 16 + jj) * NP + cp + jt * 16)[poff] = f2bf(pa[jj]); }
    LDS_BAR();
  }
}

constexpr int CH_BUF = 66560;
template <int DK, bool GLA>
__device__ void chain_attn(LAS unsigned char* lds, bf16_t* proj, const int bl, const int h, const float* esc, const int vc_base, const int nwv) {
    constexpr int QS = (DK + 8) * 2, TS = 144, MT = DK / 16, KS = DK / 32, QPR = DK / 8  ;
    constexpr int O_QT = 0, O_P = 17408, O_KTT = 26624, O_VT = 45056, O_ESC = 63488;
    constexpr int NQ = 64 * QPR, NPP = 512, NK = DK * 8, NV = 1024, NE = 3 * DK / 4;
    const int tid = opaque_tid(), lane = tid & 63, w = __builtin_amdgcn_readfirstlane(tid >> 6), fr = lane & 15, fq = lane >> 4;
    const int cq = GLA ? (C_GQ + h * 64) : (C_HQ + h * 128), ckt = GLA ? (C_GK + h * 64) : (C_HF + h * 128);
    const int cv = (GLA ? C_GV : C_HI) + h * 128, cp = (GLA ? C_GKL : C_PA) + h * 64;
    bf16_t* base = proj + (size_t)bl * SEQ * NP;
    f32x4 Sacc[MT];
#pragma unroll
    for (int m = 0; m < MT; ++m) Sacc[m] = (f32x4){0.f, 0.f, 0.f, 0.f};
    u32x4 sq[2][NQ / 512], sp[2], sk[2][NK / 512], sv[2][2], se[2];
#define CH_OFFS() \
    int t_ = tid; asm volatile("" : "+v"(t_)); \
    unsigned gq[NQ / 512], lq[NQ / 512], gk[NK / 512], lk[NK / 512], gv[2], lv[2], gp, lp; \
    _Pragma("unroll") for (int i = 0; i < NQ / 512; ++i) { const int pc = t_ + i * 512, row = pc / QPR, c8 = pc % QPR; gq[i] = (unsigned)row * NP + cq + c8 * 8; lq[i] = O_QT + row * QS + c8 * 16; } \
    { const int row = t_ >> 3, c8 = t_ & 7; gp = (unsigned)row * NP + cp + c8 * 8; lp = O_P + row * TS + c8 * 16; } \
    _Pragma("unroll") for (int i = 0; i < NK / 512; ++i) { const int pc = t_ + i * 512; \
        if (GLA) { const int kk = pc >> 3, t8 = pc & 7; gk[i] = (unsigned)kk * NP + ckt + t8 * 8; lk[i] = O_KTT + kk * TS + t8 * 16; } \
        else { const int grow = pc >> 4, c16 = pc & 15, kk = 2 * grow + (c16 >> 3); gk[i] = (unsigned)grow * NP + ckt + c16 * 8; lk[i] = O_KTT + kk * TS + (c16 & 7) * 16; } } \
    _Pragma("unroll") for (int i = 0; i < 2; ++i) { const int pc = t_ + i * 512, grow = pc >> 4, c16 = pc & 15, v = 2 * grow + (c16 >> 3); gv[i] = (unsigned)grow * NP + cv + c16 * 8; lv[i] = O_VT + v * TS + (c16 & 7) * 16; }
#define CH_LOAD(S, cc) do { CH_OFFS(); (void)lq; (void)lk; (void)lv; (void)lp; const bf16_t* tb_ = base + (size_t)(cc) * 64 * NP; \
        _Pragma("unroll") for (int i = 0; i < NQ / 512; ++i) sq[S][i] = *(const u32x4*)(tb_ + gq[i]); \
        sp[S] = *(const u32x4*)(tb_ + gp); \
        _Pragma("unroll") for (int i = 0; i < NK / 512; ++i) sk[S][i] = *(const u32x4*)(tb_ + gk[i]); \
        _Pragma("unroll") for (int i = 0; i < 2; ++i) sv[S][i] = *(const u32x4*)(tb_ + gv[i]); \
        if (t_ < NE) se[S] = *(const u32x4*)(esc + (size_t)(cc) * 3 * DK + t_ * 4); } while (0)
#define CH_STORE(S, bufo) do { CH_OFFS(); (void)gq; (void)gk; (void)gv; (void)gp; \
        _Pragma("unroll") for (int i = 0; i < NQ / 512; ++i) *(LAS u32x4*)(lds + (bufo) + lq[i]) = sq[S][i]; \
        *(LAS u32x4*)(lds + (bufo) + lp) = sp[S]; \
        _Pragma("unroll") for (int i = 0; i < NK / 512; ++i) *(LAS u32x4*)(lds + (bufo) + lk[i]) = sk[S][i]; \
        _Pragma("unroll") for (int i = 0; i < 2; ++i) *(LAS u32x4*)(lds + (bufo) + lv[i]) = sv[S][i]; \
        if (t_ < NE) *(LAS u32x4*)(lds + (bufo) + O_ESC + t_ * 16) = se[S]; } while (0)
#define CH_STEP(S, c) do { \
        const int bo = ((c) & 1) * CH_BUF; \
        if (w < nwv) { \
        LAS float* e1 = (LAS float*)(lds + bo + O_ESC); LAS float* e2 = e1 + DK; LAS float* dd = e1 + 2 * DK; \
        bf16x8 Bv[2], Sb[KS]; \
        _Pragma("unroll") for (int ks = 0; ks < 2; ++ks) Bv[ks] = *(const LAS bf16x8*)(lds + bo + O_VT + (vc0 + fr) * TS + (ks * 32 + fq * 8) * 2); \
        _Pragma("unroll") for (int ks = 0; ks < KS; ++ks) { const f32x4 ea = *(const LAS f32x4*)(e1 + (2 * ks) * 16 + 4 * fq), eb = *(const LAS f32x4*)(e1 + (2 * ks + 1) * 16 + 4 * fq); \
            const f32x4 sa = Sacc[2 * ks] * ea, sb = Sacc[2 * ks + 1] * eb; \
            u32x4 wv; wv.x = cvt_pk_bf16(sa[0], sa[1]); wv.y = cvt_pk_bf16(sa[2], sa[3]); wv.z = cvt_pk_bf16(sb[0], sb[1]); wv.w = cvt_pk_bf16(sb[2], sb[3]); \
            __builtin_memcpy(&Sb[ks], &wv, 16); } \
        bf16_t* tb = base + (size_t)(c) * 64 * NP; \
        bf16_t* op = tb + ((vc0 >> 1) + (fr >> 1)) * NP + cv + (fr & 1) * 64 + 4 * fq; \
        _Pragma("unroll") for (int m = 0; m < 4; ++m) { f32x4 a4 = (f32x4){0.f, 0.f, 0.f, 0.f}; \
            _Pragma("unroll") for (int ks = 0; ks < 2; ++ks) { if (ks == 1 && m < 2) continue; \
                const bf16x8 a = *(const LAS bf16x8*)(lds + bo + O_P + (m * 16 + fr) * TS + (ks * 32 + fq * 8) * 2); a4 = MFMA16(a, Bv[ks], a4); } \
            _Pragma("unroll") for (int ks = 0; ks < KS; ++ks) { const bf16x8 a = *(const LAS bf16x8*)(lds + bo + O_QT + (m * 16 + fr) * QS + (ks * 32 + fq * 8) * 2); a4 = MFMA16(a, Sb[ks], a4); } \
            u32x2 ow; ow.x = cvt_pk_bf16(a4[0], a4[1]); ow.y = cvt_pk_bf16(a4[2], a4[3]); \
            *(u32x2*)(op + m * 16) = ow; } \
        _Pragma("unroll") for (int m = 0; m < MT; ++m) { f32x4 t4 = (f32x4){0.f, 0.f, 0.f, 0.f}; \
            _Pragma("unroll") for (int ks = 0; ks < 2; ++ks) { const bf16x8 a = *(const LAS bf16x8*)(lds + bo + O_KTT + (m * 16 + fr) * TS + (ks * 32 + fq * 8) * 2); t4 = MFMA16(a, Bv[ks], t4); } \
            const f32x4 d4 = *(const LAS f32x4*)(dd + m * 16 + 4 * fq), e4 = *(const LAS f32x4*)(e2 + m * 16 + 4 * fq); \
            Sacc[m] = Sacc[m] * d4 + t4 * e4; } } \
        if ((c) < 63) CH_STORE(S, (((c) + 1) & 1) * CH_BUF); \
        if ((c) < 61) CH_LOAD(S, (c) + 3); \
        LDS_BAR(); } while (0)
    const int vc0 = vc_base + 16 * w;
    CH_LOAD(0, 0); CH_STORE(0, 0);
    CH_LOAD(0, 1); CH_LOAD(1, 2);
    LDS_BAR();
    for (int c = 0; c < 64; c += 2) {
        CH_STEP(0, c);
        CH_STEP(1, c + 1);
    }
#undef CH_LOAD
#undef CH_STORE
#undef CH_STEP
#undef CH_OFFS
}

__device__ void chain_hg_half(LAS unsigned char* lds, bf16_t* proj, const int bl, const int h, const float* esc, const int vc_base) {
    constexpr int DK = 128, QS = 272, TS = 144, MT = 8, KS = 4;
    constexpr int O_QT = 0, O_P = 17408, O_KTT = 26624, O_VT = 45056, O_ESC = 63488;
    const int tid = opaque_tid(), lane = tid & 63, w = __builtin_amdgcn_readfirstlane(tid >> 6), fr = lane & 15, fq = lane >> 4;
    const int cq = C_HQ + h * 128, ckt = C_HF + h * 128, cv = C_HI + h * 128, cp = C_PA + h * 64;
    bf16_t* base = proj + (size_t)bl * SEQ * NP;
    if (w >= 4) {
        const int lt = tid - 256;
        u32x4 r[3][13];
#define HL_OFFS() \
        int t_ = lt; asm volatile("" : "+v"(t_)); unsigned go[13], lo[13]; \
        _Pragma("unroll") for (int i = 0; i < 4; ++i) { const int pc = t_ + i * 256, row = pc >> 4, c8 = pc & 15; go[i] = (unsigned)row * NP + cq + c8 * 8; lo[i] = O_QT + row * QS + c8 * 16; } \
        _Pragma("unroll") for (int i = 0; i < 2; ++i) { const int pc = t_ + i * 256, row = pc >> 3, c8 = pc & 7; go[4 + i] = (unsigned)row * NP + cp + c8 * 8; lo[4 + i] = O_P + row * TS + c8 * 16; } \
        _Pragma("unroll") for (int i = 0; i < 4; ++i) { const int pc = t_ + i * 256, grow = pc >> 4, c16 = pc & 15, kk = 2 * grow + (c16 >> 3); go[6 + i] = (unsigned)grow * NP + ckt + c16 * 8; lo[6 + i] = O_KTT + kk * TS + (c16 & 7) * 16; } \
        _Pragma("unroll") for (int i = 0; i < 2; ++i) { const int pc = t_ + i * 256, grow = (vc_base >> 1) + (pc >> 4), c16 = pc & 15, v = 2 * grow + (c16 >> 3); go[10 + i] = (unsigned)grow * NP + cv + c16 * 8; lo[10 + i] = O_VT + v * TS + (c16 & 7) * 16; }
#define HL_LOAD(S, cc) do { HL_OFFS(); (void)lo; const bf16_t* tb_ = base + (size_t)(cc) * 64 * NP; \
        _Pragma("unroll") for (int i = 0; i < 12; ++i) r[S][i] = *(const u32x4*)(tb_ + go[i]); \
        if (t_ < 96) r[S][12] = *(const u32x4*)(esc + (size_t)(cc) * 3 * DK + t_ * 4); } while (0)
#define HL_STORE(S, bufo) do { HL_OFFS(); (void)go; \
        _Pragma("unroll") for (int i = 0; i < 12; ++i) *(LAS u32x4*)(lds + (bufo) + lo[i]) = r[S][i]; \
        if (t_ < 96) *(LAS u32x4*)(lds + (bufo) + O_ESC + t_ * 16) = r[S][12]; } while (0)
#define HL_STEP(S, c) do { if ((c) < 63) HL_STORE(S, (((c) + 1) & 1) * CH_BUF); if ((c) + 4 < 64) HL_LOAD(S, (c) + 4); LDS_BAR(); } while (0)
        HL_LOAD(0, 0); HL_STORE(0, 0);
        HL_LOAD(0, 1); HL_LOAD(1, 2); HL_LOAD(2, 3);
        LDS_BAR();
        for (int c = 0; c < 63; c += 3) { HL_STEP(0, c); HL_STEP(1, c + 1); HL_STEP(2, c + 2); }
        HL_STEP(0, 63);
#undef HL_OFFS
#undef HL_LOAD
#undef HL_STORE
#undef HL_STEP
    } else {
        const int vc0 = vc_base + 16 * w;
        f32x4 Sacc[MT];
#pragma unroll
        for (int m = 0; m < MT; ++m) Sacc[m] = (f32x4){0.f, 0.f, 0.f, 0.f};
        LDS_BAR();
        for (int c = 0; c < 64; ++c) {
            const int bo = (c & 1) * CH_BUF;
            LAS float* e1 = (LAS float*)(lds + bo + O_ESC); LAS float* e2 = e1 + DK; LAS float* dd = e1 + 2 * DK;
            bf16x8 Bv[2], Sb[KS];
#pragma unroll
            for (int ks = 0; ks < 2; ++ks) Bv[ks] = *(const LAS bf16x8*)(lds + bo + O_VT + (vc0 + fr) * TS + (ks * 32 + fq * 8) * 2);
#pragma unroll
            for (int ks = 0; ks < KS; ++ks) { const f32x4 ea = *(const LAS f32x4*)(e1 + (2 * ks) * 16 + 4 * fq), eb = *(const LAS f32x4*)(e1 + (2 * ks + 1) * 16 + 4 * fq);
                const f32x4 sa = Sacc[2 * ks] * ea, sb = Sacc[2 * ks + 1] * eb;
                u32x4 wv; wv.x = cvt_pk_bf16(sa[0], sa[1]); wv.y = cvt_pk_bf16(sa[2], sa[3]); wv.z = cvt_pk_bf16(sb[0], sb[1]); wv.w = cvt_pk_bf16(sb[2], sb[3]);
                __builtin_memcpy(&Sb[ks], &wv, 16); }
            bf16_t* tb = base + (size_t)c * 64 * NP;
            bf16_t* op = tb + ((vc0 >> 1) + (fr >> 1)) * NP + cv + (fr & 1) * 64 + 4 * fq;
#pragma unroll
            for (int m = 0; m < 4; ++m) { f32x4 a4 = (f32x4){0.f, 0.f, 0.f, 0.f};
#pragma unroll
                for (int ks = 0; ks < 2; ++ks) { if (ks == 1 && m < 2) continue;
                    const bf16x8 a = *(const LAS bf16x8*)(lds + bo + O_P + (m * 16 + fr) * TS + (ks * 32 + fq * 8) * 2); a4 = MFMA16(a, Bv[ks], a4); }
#pragma unroll
                for (int ks = 0; ks < KS; ++ks) { const bf16x8 a = *(const LAS bf16x8*)(lds + bo + O_QT + (m * 16 + fr) * QS + (ks * 32 + fq * 8) * 2); a4 = MFMA16(a, Sb[ks], a4); }
                u32x2 ow; ow.x = cvt_pk_bf16(a4[0], a4[1]); ow.y = cvt_pk_bf16(a4[2], a4[3]);
                *(u32x2*)(op + m * 16) = ow; }
#pragma unroll
            for (int m = 0; m < MT; ++m) { f32x4 t4 = (f32x4){0.f, 0.f, 0.f, 0.f};
#pragma unroll
                for (int ks = 0; ks < 2; ++ks) { const bf16x8 a = *(const LAS bf16x8*)(lds + bo + O_KTT + (m * 16 + fr) * TS + (ks * 32 + fq * 8) * 2); t4 = MFMA16(a, Bv[ks], t4); }
                const f32x4 d4 = *(const LAS f32x4*)(dd + m * 16 + 4 * fq), e4 = *(const LAS f32x4*)(e2 + m * 16 + 4 * fq);
                Sacc[m] = Sacc[m] * d4 + t4 * e4; }
            LDS_BAR();
        }
    }
}

__device__ void post_attn(LAS unsigned char* lds, bf16_t* proj, const int bl, const int h, const int c, const bool gla, const float* nwp) {
    const int tid = opaque_tid();
    const int cv = (gla ? C_GV : C_HI) + h * 128, cg = (gla ? C_GG : C_HG) + h * 128;
    bf16_t* t0 = proj + ((size_t)bl * SEQ + (size_t)c * 64) * NP;
    LAS float* ot = (LAS float*)lds;
    {
#pragma unroll
      for (int i = 0; i < 2; ++i) { const int pc = tid + i * 512, grow = pc >> 4, c16 = pc & 15, v = 2 * grow + (c16 >> 3), tk = (c16 & 7) * 8;
          const u32x4 x = *(const u32x4*)(t0 + (unsigned)grow * NP + cv + c16 * 8);
          ot[(tk + 0) * 132 + v] = __uint_as_float(x.x << 16); ot[(tk + 1) * 132 + v] = __uint_as_float(x.x & 0xffff0000u);
          ot[(tk + 2) * 132 + v] = __uint_as_float(x.y << 16); ot[(tk + 3) * 132 + v] = __uint_as_float(x.y & 0xffff0000u);
          ot[(tk + 4) * 132 + v] = __uint_as_float(x.z << 16); ot[(tk + 5) * 132 + v] = __uint_as_float(x.z & 0xffff0000u);
          ot[(tk + 6) * 132 + v] = __uint_as_float(x.w << 16); ot[(tk + 7) * 132 + v] = __uint_as_float(x.w & 0xffff0000u); } }
    LDS_BAR();
    const int tok = tid >> 3, v8 = tid & 7;
    f32x4 o[4]; float s = 0.f;
#pragma unroll
    for (int i = 0; i < 4; ++i) { o[i] = *(const LAS f32x4*)(ot + tok * 132 + v8 * 16 + i * 4); s += o[i][0] * o[i][0] + o[i][1] * o[i][1] + o[i][2] * o[i][2] + o[i][3] * o[i][3]; }
    s += __shfl_xor(s, 1); s += __shfl_xor(s, 2); s += __shfl_xor(s, 4);
    const float rs = rsqrtf(s * (1.0f / 128.0f) + NORM_EPS);
    bf16_t* gp = t0 + (unsigned)tok * NP + cg + v8 * 16;
    const u32x4 g0 = *(const u32x4*)gp, g1 = *(const u32x4*)(gp + 8);
    const unsigned gw[8] = {g0.x, g0.y, g0.z, g0.w, g1.x, g1.y, g1.z, g1.w};
    unsigned yw[8];
#pragma unroll
    for (int i = 0; i < 8; ++i) { const float ga = __uint_as_float(gw[i] << 16), gb = __uint_as_float(gw[i] & 0xffff0000u);
        const float oa = o[i >> 1][(i & 1) * 2], ob = o[i >> 1][(i & 1) * 2 + 1];
        const float na = nwp[v8 * 16 + i * 2], nb = nwp[v8 * 16 + i * 2 + 1];
        yw[i] = cvt_pk_bf16(oa * rs * na * silu(ga), ob * rs * nb * silu(gb)); }
    u32x4 y0, y1; y0.x = yw[0]; y0.y = yw[1]; y0.z = yw[2]; y0.w = yw[3]; y1.x = yw[4]; y1.y = yw[5]; y1.z = yw[6]; y1.w = yw[7];
    *(u32x4*)gp = y0; *(u32x4*)(gp + 8) = y1;
    LDS_BAR();
}

template <int M0, int NKT>
__device__ __forceinline__ void sg_pass(LAS unsigned char* lds, bf16_t* t0, const float* w_s, const float* b_s, const int g, const int cb, const int fr, const int fq) {
    constexpr int VS = 272;
    f32x4 acc[4][4];
#pragma unroll
    for (int m = 0; m < 4; ++m)
#pragma unroll
        for (int n = 0; n < 4; ++n) acc[m][n] = (f32x4){0.f, 0.f, 0.f, 0.f};
    const unsigned aoff = (unsigned)fr * 128 + fq * 8;
    const float* wbase = w_s + (g * 128 + M0 * 16) * 128;
    f32x4 nf[4][2];
#pragma unroll
    for (int m = 0; m < 4; ++m) { const float* wp = wbase + m * 16 * 128; nf[m][0] = *(const f32x4*)(wp + aoff); nf[m][1] = *(const f32x4*)(wp + aoff + 4); }
#pragma unroll
    for (int kt = 0; kt < NKT; ++kt) { bf16x8 B[4], A[4];
#pragma unroll
        for (int m = 0; m < 4; ++m) { u32x4 aw; aw.x = cvt_pk_bf16(nf[m][0][0], nf[m][0][1]); aw.y = cvt_pk_bf16(nf[m][0][2], nf[m][0][3]); aw.z = cvt_pk_bf16(nf[m][1][0], nf[m][1][1]); aw.w = cvt_pk_bf16(nf[m][1][2], nf[m][1][3]);
            __builtin_memcpy(&A[m], &aw, 16); }
        if (kt + 1 < NKT) {
#pragma unroll
            for (int m = 0; m < 4; ++m) { const float* wp = wbase + m * 16 * 128 + (kt + 1) * 32; nf[m][0] = *(const f32x4*)(wp + aoff); nf[m][1] = *(const f32x4*)(wp + aoff + 4); } }
#pragma unroll
        for (int n = 0; n < 4; ++n) B[n] = *(const LAS bf16x8*)(lds + (cb + n * 16 + fr) * VS + (kt * 32 + fq * 8) * 2);
#pragma unroll
        for (int m = 0; m < 4; ++m)
#pragma unroll
            for (int n = 0; n < 4; ++n) acc[m][n] = MFMA16(A[m], B[n], acc[m][n]); }
    const unsigned roff = (unsigned)(4 * fq) * NP + fr;
#pragma unroll
    for (int m = 0; m < 4; ++m)
#pragma unroll
        for (int jj = 0; jj < 4; ++jj) { const float bs = b_s[g * 128 + (M0 + m) * 16 + 4 * fq + jj]; bf16_t* rp = t0 + ((M0 + m) * 16 + jj) * NP + C_SV + cb;
#pragma unroll
            for (int n = 0; n < 4; ++n) (rp + n * 16)[roff] = f2bf(acc[m][n][jj] + bs); }
}
__device__ void sg_unit(LAS unsigned char* lds, bf16_t* proj, const int tok0, const float* ln_w, const float* ln_b, const float* w_s, const float* b_s) {
    constexpr int VS = 272;
    const int tid = opaque_tid(), lane = tid & 63, w = __builtin_amdgcn_readfirstlane(tid >> 6), fr = lane & 15, fq = lane >> 4;
    bf16_t* t0 = proj + (size_t)tok0 * NP;
    {   float lw[8], lbv[8];
#pragma unroll
        for (int e = 0; e < 8; ++e) { lw[e] = ln_w[lane + 64 * e]; lbv[e] = ln_b[lane + 64 * e]; }
        bf16_t rv[4][8];
#pragma unroll
        for (int s = 0; s < 4; ++s)
#pragma unroll
            for (int e = 0; e < 8; ++e) rv[s][e] = (t0 + (w * 16 + s) * NP + C_SV + 64 * e)[(unsigned)lane];
        for (int it = 0; it < 4; ++it) { float x[4][8], sm[4], sq[4];
#pragma unroll
            for (int s = 0; s < 4; ++s) { sm[s] = 0.f; sq[s] = 0.f;
#pragma unroll
                for (int e = 0; e < 8; ++e) { x[s][e] = gelu_erf(bf2f(rv[s][e])); sm[s] += x[s][e]; sq[s] += x[s][e] * x[s][e]; } }
            if (it < 3) {
#pragma unroll
                for (int s = 0; s < 4; ++s)
#pragma unroll
                    for (int e = 0; e < 8; ++e) rv[s][e] = (t0 + (w * 16 + (it + 1) * 4 + s) * NP + C_SV + 64 * e)[(unsigned)lane]; }
#pragma unroll
            for (int o = 32; o >= 1; o >>= 1) {
#pragma unroll
                for (int s = 0; s < 4; ++s) { sm[s] += __shfl_xor(sm[s], o); sq[s] += __shfl_xor(sq[s], o); } }
#pragma unroll
            for (int s = 0; s < 4; ++s) { const float mu = sm[s] * (1.0f / 512.0f); const float var = fmaxf(sq[s] * (1.0f / 512.0f) - mu * mu, 0.f); const float rs = rsqrtf(var + NORM_EPS);
#pragma unroll
                for (int e = 0; e < 8; ++e) x[s][e] = (x[s][e] - mu) * rs * lw[e] + lbv[e]; }
#pragma unroll
            for (int e = 0; e < 8; ++e) { LAS unsigned* dp = (LAS unsigned*)(lds + (lane + 64 * e) * VS + (w * 16 + it * 4) * 2);
                dp[0] = cvt_pk_bf16(x[0][e], x[1][e]); dp[1] = cvt_pk_bf16(x[2][e], x[3][e]); } } }
    LDS_BAR();
    const int g = w >> 1, cb = g * 128 + (w & 1) * 64;
    sg_pass<0, 2>(lds, t0, w_s, b_s, g, cb, fr, fq);
    sg_pass<4, 4>(lds, t0, w_s, b_s, g, cb, fr, fq);
    LDS_BAR();
}
__device__ void sg_post(bf16_t* proj, const int tok0) {
    const int tid = opaque_tid(); const int c8 = tid & 63, tr = tid >> 6;
    bf16_t* t0 = proj + ((size_t)tok0 + tr * 8) * NP + c8 * 8;
#pragma unroll
    for (int e = 0; e < 8; ++e) { bf16_t* gp = t0 + e * NP + C_SGT;
        const u32x4 uu = *(const u32x4*)(t0 + e * NP + C_SU), mm = *(const u32x4*)(t0 + e * NP + C_SV), gg = *(const u32x4*)gp;
        const unsigned ua[4] = {uu.x, uu.y, uu.z, uu.w}, ma[4] = {mm.x, mm.y, mm.z, mm.w}, ga[4] = {gg.x, gg.y, gg.z, gg.w}; unsigned o[4];
#pragma unroll
        for (int i = 0; i < 4; ++i) { const float u0 = __uint_as_float(ua[i] << 16), u1 = __uint_as_float(ua[i] & 0xffff0000u), m0 = __uint_as_float(ma[i] << 16), m1 = __uint_as_float(ma[i] & 0xffff0000u);
            const float g0 = __uint_as_float(ga[i] << 16), g1 = __uint_as_float(ga[i] & 0xffff0000u);
            o[i] = cvt_pk_bf16(gelu_erf(u0) * m0 * silu(g0), gelu_erf(u1) * m1 * silu(g1)); }
        u32x4 ov; ov.x = o[0]; ov.y = o[1]; ov.z = o[2]; ov.w = o[3]; *(u32x4*)gp = ov; }
}

constexpr int LR_XCB = 0, LR_XCF = 17408, LR_SA = 50176, LR_SB = 82944, LR_CA = 115712  , LR_CH = 117760;
__device__ void lru_prep(LAS unsigned char* lds, bf16_t* proj, const int bl, const int h, const int c0, const float* conv_w, const float* conv_b, const float* w_a, const float* b_a,
                         const float* w_x, const float* b_x, const float* lam, float* car  ) {
    const int tid = opaque_tid(), lane = tid & 63, w = __builtin_amdgcn_readfirstlane(tid >> 6), fr = lane & 15, fq = lane >> 4;
    const int ci = tid & 127, tq = tid >> 7; const int ch = h * 128 + ci;
    float cw[4]; const float cbias = conv_b[ch];
#pragma unroll
    for (int t = 0; t < 4; ++t) cw[t] = conv_w[t * 512 + ch];
    const int jch = h * 128 + w * 16 + fr;
    const float ba = b_a[jch], bx = b_x[jch];
    float c8; { const float nl = -lam[jch]; const float sp = fmaxf(nl, 0.f) + __logf(1.0f + __expf(-fabsf(nl))); c8 = -8.0f * sp; }
    bf16x8 Ba[4], Bx[4];
    { const int j = w * 16 + fr;
#pragma unroll
      for (int ks = 0; ks < 4; ++ks) { float fa[8], fx[8];
#pragma unroll
          for (int e = 0; e < 8; ++e) { const unsigned o = (unsigned)(h * 128 + ks * 32 + fq * 8 + e) * 128 + j; fa[e] = w_a[o]; fx[e] = w_x[o]; }
          u32x4 wa, wx; wa.x = cvt_pk_bf16(fa[0], fa[1]); wa.y = cvt_pk_bf16(fa[2], fa[3]); wa.z = cvt_pk_bf16(fa[4], fa[5]); wa.w = cvt_pk_bf16(fa[6], fa[7]);
          wx.x = cvt_pk_bf16(fx[0], fx[1]); wx.y = cvt_pk_bf16(fx[2], fx[3]); wx.z = cvt_pk_bf16(fx[4], fx[5]); wx.w = cvt_pk_bf16(fx[6], fx[7]);
          __builtin_memcpy(&Ba[ks], &wa, 16); __builtin_memcpy(&Bx[ks], &wx, 16); } }
    LAS float* xcf = (LAS float*)(lds + LR_XCF); LAS float* sa = (LAS float*)(lds + LR_SA); LAS float* sb = (LAS float*)(lds + LR_SB);
    LAS float* ca = (LAS float*)(lds + LR_CA); LAS float* chh = (LAS float*)(lds + LR_CH);
    bf16_t* base = proj + (size_t)bl * SEQ * NP;
    const int xoff = (tq * 16) * NP + ch;
    bf16_t xr[19], rgt[16];
#pragma unroll
    for (int e = 0; e < 19; ++e) { const int s = c0 * 64 + tq * 16 - 3 + e; xr[e] = (s >= 0) ? (base + (c0 * 64 - 3 + e) * NP + C_RX)[xoff] : (bf16_t)0; }
#pragma unroll
    for (int e = 0; e < 16; ++e) rgt[e] = (base + (c0 * 64 + e) * NP + C_RG)[xoff];
  for (int cc = 0; cc < PREP_NCH; ++cc) { const int c = c0 + cc;
    bf16_t* t0 = base + (size_t)c * 64 * NP;
    { float xv[19];
#pragma unroll
        for (int e = 0; e < 19; ++e) xv[e] = bf2f(xr[e]);
#pragma unroll
        for (int e = 0; e < 16; ++e) { const float xc = cbias + cw[0] * xv[e] + cw[1] * xv[e + 1] + cw[2] * xv[e + 2] + cw[3] * xv[e + 3]; const int t = tq * 16 + e;
            xcf[t * 128 + ci] = xc; *(LAS bf16_t*)(lds + LR_XCB + t * 272 + ci * 2) = f2bf(xc); } }
    float sg[16];
#pragma unroll
    for (int e = 0; e < 16; ++e) sg[e] = silu(bf2f(rgt[e]));
    LDS_BAR();
    if (cc + 1 < PREP_NCH) {
#pragma unroll
        for (int e = 0; e < 19; ++e) xr[e] = (t0 + (64 - 3 + e) * NP + C_RX)[xoff];
#pragma unroll
        for (int e = 0; e < 16; ++e) rgt[e] = (t0 + (64 + e) * NP + C_RG)[xoff]; }
#pragma unroll
    for (int m = 0; m < 4; ++m) { f32x4 aa = (f32x4){0.f, 0.f, 0.f, 0.f}, ax = aa;
#pragma unroll
        for (int ks = 0; ks < 4; ++ks) { const bf16x8 a = *(const LAS bf16x8*)(lds + LR_XCB + (m * 16 + fr) * 272 + (ks * 32 + fq * 8) * 2); aa = MFMA16(a, Ba[ks], aa); ax = MFMA16(a, Bx[ks], ax); }
#pragma unroll
        for (int jj = 0; jj < 4; ++jj) { const int t = m * 16 + 4 * fq + jj; const float r = sigm(aa[jj] + ba), ig = sigm(ax[jj] + bx);
            const float la = c8 * r; const float av = __expf(la); const float x2 = 2.0f * la;
            const float om = (x2 > -0.02f) ? -x2 * (1.0f + x2 * (0.5f + x2 * (1.0f / 6.0f))) : 1.0f - __expf(x2);
            const float bt = sqrtf(fmaxf(om, 1e-12f)) * ig * xcf[t * 128 + w * 16 + fr];
            sa[t * 128 + w * 16 + fr] = av; sb[t * 128 + w * 16 + fr] = bt; } }
    LDS_BAR();
    float hl[16], ac[16]; { float hloc = 0.f, A = 1.f;
#pragma unroll
        for (int e = 0; e < 16; ++e) { const float a = sa[(tq * 16 + e) * 128 + ci], b = sb[(tq * 16 + e) * 128 + ci]; hloc = a * hloc + b; A *= a; hl[e] = hloc; ac[e] = A; }
        ca[tq * 128 + ci] = A; chh[tq * 128 + ci] = hloc; }
    LDS_BAR();
    { float Hq = 0.f, Hn = 0.f, Aq = 1.f, An = 1.f;
#pragma unroll
        for (int q2 = 0; q2 < 4; ++q2) { const float A = ca[q2 * 128 + ci], hh = chh[q2 * 128 + ci]; Hn = A * Hn + hh; An *= A; if (q2 < tq) { Hq = Hn; Aq = An; } }
        if (tq == 0) { f32x2 cv2 = {An, Hn}; *(f32x2*)(car + ((size_t)c * 512 + ch) * 2) = cv2; }
#pragma unroll
        for (int e = 0; e < 16; ++e) { const float hv = hl[e] + ac[e] * Hq;
            (t0 + e * NP + C_RG)[xoff] = f2bf(hv * sg[e]); (t0 + e * NP + C_Z)[xoff] = f2bf(ac[e] * Aq * sg[e]); } }
    LDS_BAR();
  }
}
__device__ void lru_scan(const float* car, float* hin) {
    const int ch = opaque_tid(); float H = 0.f;
    for (int c = 0; c < 64; c += 8) { f32x2 v[8];
#pragma unroll
        for (int e = 0; e < 8; ++e) v[e] = *(const f32x2*)(car + ((size_t)(c + e) * 512 + ch) * 2);
#pragma unroll
        for (int e = 0; e < 8; ++e) { hin[(size_t)(c + e) * 512 + ch] = H; H = v[e][0] * H + v[e][1]; } }
}
__device__ void lru_post(bf16_t* proj, const int bl, const int c, const float* hin  ) {
    const int tid = opaque_tid(); const int c8 = tid & 63, tr = tid >> 6;
    bf16_t* t0 = proj + ((size_t)bl * SEQ + (size_t)c * 64 + tr * 8) * NP;
    const f32x4 h0 = *(const f32x4*)(hin + (size_t)c * 512 + c8 * 8), h1 = *(const f32x4*)(hin + (size_t)c * 512 + c8 * 8 + 4);
#pragma unroll
    for (int e = 0; e < 8; ++e) { bf16_t* yp = t0 + e * NP + C_RG + c8 * 8; const bf16_t* zp = t0 + e * NP + C_Z + c8 * 8;
        const u32x4 y = *(const u32x4*)yp, z = *(const u32x4*)zp; u32x4 o;
        o.x = cvt_pk_bf16(__uint_as_float(y.x << 16) + __uint_as_float(z.x << 16) * h0[0], __uint_as_float(y.x & 0xffff0000u) + __uint_as_float(z.x & 0xffff0000u) * h0[1]);
        o.y = cvt_pk_bf16(__uint_as_float(y.y << 16) + __uint_as_float(z.y << 16) * h0[2], __uint_as_float(y.y & 0xffff0000u) + __uint_as_float(z.y & 0xffff0000u) * h0[3]);
        o.z = cvt_pk_bf16(__uint_as_float(y.z << 16) + __uint_as_float(z.z << 16) * h1[0], __uint_as_float(y.z & 0xffff0000u) + __uint_as_float(z.z & 0xffff0000u) * h1[1]);
        o.w = cvt_pk_bf16(__uint_as_float(y.w << 16) + __uint_as_float(z.w << 16) * h1[2], __uint_as_float(y.w & 0xffff0000u) + __uint_as_float(z.w & 0xffff0000u) * h1[3]);
        *(u32x4*)yp = o; }
}

#define XB_TMO      128
#define XB_XCNT(j)  (256  + 64 * (j))
#define XB_XSUB(j)  (1280 + 64 * (j))
#define XB_XGEN(j)  (2304 + 64 * (j))
#define XB_TOP      3328
#define XB_TOPGEN   3392
#define XCD_BAR_WORDS 3456
#define XB_SPIN_CAP (1u << 18)
__device__ __forceinline__ unsigned xb_ld(unsigned* p)              { return __hip_atomic_load(p, __ATOMIC_RELAXED, __HIP_MEMORY_SCOPE_AGENT); }
__device__ __forceinline__ unsigned xb_add(unsigned* p, unsigned v) { return __hip_atomic_fetch_add(p, v, __ATOMIC_RELAXED, __HIP_MEMORY_SCOPE_AGENT); }
__device__ __forceinline__ unsigned xb_xcc_id() { return (unsigned)__builtin_amdgcn_s_getreg((3 << 11) | 20) & 0xFu; }
#define XB_SPIN(cond, bar) do { unsigned _sp = 0; while (cond) { __builtin_amdgcn_s_sleep(1); \
    if ((++_sp & 255u) == 0u) { if (xb_ld(&(bar)[XB_TMO])) break; if (_sp > XB_SPIN_CAP) { atomicAdd(&(bar)[XB_TMO], 1u); break; } } } } while (0)
struct XcdBarrier { unsigned* bar; unsigned x; volatile LAS unsigned* st; };
__device__ __forceinline__ XcdBarrier xcd_barrier_post(unsigned* bar, volatile LAS unsigned* st) {
    XcdBarrier b; b.bar = bar; b.x = xb_xcc_id(); b.st = st;
    if (threadIdx.x == 0) (void)xb_add(&bar[XB_XCNT(b.x)], 1u);
    return b;
}
__device__ __forceinline__ void xcd_barrier_complete(unsigned* bar, unsigned x, unsigned& nloc, unsigned& nx) {
    const unsigned G = gridDim.x * gridDim.y * gridDim.z;
    unsigned sum, cnt, mine, sp = 0u;
    for (;;) {
        sum = 0u; cnt = 0u; mine = 0u;
#pragma unroll
        for (unsigned j = 0; j < 16; ++j) { const unsigned c = xb_ld(&bar[XB_XCNT(j)]); sum += c; cnt += (c > 0u) ? 1u : 0u; mine = (j == x) ? c : mine; }
        if (sum == G) break;
        __builtin_amdgcn_s_sleep(1);
        if ((++sp & 255u) == 0u) { if (xb_ld(&bar[XB_TMO])) break; if (sp > XB_SPIN_CAP) { atomicAdd(&bar[XB_TMO], 1u); break; } }
    }
    nloc = mine > 0u ? mine : 1u; nx = cnt > 0u ? cnt : 1u;
}
__device__ __forceinline__ void xcd_barrier(const XcdBarrier& b) {
    asm volatile("s_waitcnt vmcnt(0)" ::: "memory");
    __syncthreads();
    if (threadIdx.x == 0) {
        unsigned* bar = b.bar;
        __builtin_amdgcn_s_waitcnt(0);
        unsigned nloc = b.st[0], nx = b.st[1];
        if (nloc == 0u) { xcd_barrier_complete(bar, b.x, nloc, nx); b.st[0] = nloc; b.st[1] = nx; }
        const unsigned old = xb_add(&bar[XB_XSUB(b.x)], 1u);
        const unsigned gen = old / nloc;
        if (old + 1u == (gen + 1u) * nloc) {
            __builtin_amdgcn_fence(__ATOMIC_RELEASE, "agent");
            asm volatile("s_waitcnt vmcnt(0)" ::: "memory");
            const unsigned og = xb_add(&bar[XB_TOP], 1u);
            const unsigned tg = og / nx;
            if (og + 1u == (tg + 1u) * nx) xb_add(&bar[XB_TOPGEN], 1u);
            else XB_SPIN(xb_ld(&bar[XB_TOPGEN]) == tg, bar);
            __builtin_amdgcn_fence(__ATOMIC_ACQUIRE, "agent");
            xb_add(&bar[XB_XGEN(b.x)], 1u);
            asm volatile("s_waitcnt vmcnt(0)" ::: "memory");
        } else {
            XB_SPIN(xb_ld(&bar[XB_XGEN(b.x)]) == gen, bar);
            __builtin_amdgcn_fence(__ATOMIC_ACQUIRE, "agent");
            asm volatile("s_waitcnt vmcnt(0)" ::: "memory");
        }
    }
    __syncthreads();
}

#define GRID_SYNC() do { asm volatile("s_waitcnt vmcnt(0) lgkmcnt(0)" ::: "memory"); __syncthreads(); grid.sync(); asm volatile("" ::: "memory"); } while (0)
__device__ __forceinline__ int next_unit(unsigned* ctr, LAS unsigned char* lds) {
    LAS int* slot = (LAS int*)(lds + LDS_BYTES - 16);
    if (threadIdx.x == 0) *slot = (int)__hip_atomic_fetch_add(ctr, 1u, __ATOMIC_RELAXED, __HIP_MEMORY_SCOPE_AGENT);
    LDS_BAR();
    const int u = *slot;
    LDS_BAR();
    return __builtin_amdgcn_readfirstlane(u);
}
constexpr int N_CHAIN_BLOCKS = 56;
constexpr int GATES_EARLY = 24;
__global__ void __launch_bounds__(512) mega(Params p) {
    extern __shared__ __attribute__((aligned(16))) unsigned char smem[];
    LAS unsigned char* lds = (LAS unsigned char*)smem;
    cg::grid_group grid = cg::this_grid();
    const int G = gridDim.x;
    unsigned char* ws = p.ws;
    bf16_t* proj = (bf16_t*)(ws + WS_PROJ); unsigned char* gates = ws + WS_GATES; bf16_t* hb = (bf16_t*)(ws + WS_HB);
    bf16_t* part = (bf16_t*)(ws + WS_PART); float* rstd = (float*)(ws + WS_RSTD);
    float* escA = (float*)(ws + WS_ESCA); float* escB = (float*)(ws + WS_ESCB); float* car = (float*)(ws + WS_CAR); float* hin = (float*)(ws + WS_HIN);

    volatile LAS unsigned* xst = (volatile LAS unsigned*)(lds + LDS_BYTES - 32);
    if (threadIdx.x == 0) { xst[0] = 0u; xst[1] = 0u; }
    if (blockIdx.x == 0) { unsigned* ctl = (unsigned*)(ws + WS_CTL);
        for (int i = threadIdx.x; i < (4096 + 16384) / 4; i += 512) __hip_atomic_store(ctl + i, 0u, __ATOMIC_RELAXED, __HIP_MEMORY_SCOPE_AGENT); }
    __syncthreads();
    prologue_phase(p, lds, G);
    pre_phase(p.in[0], (bf16_t*)(ws + WS_HB), (float*)(ws + WS_RSTD), G);
    GRID_SYNC();
    const XcdBarrier xbar = xcd_barrier_post((unsigned*)(ws + WS_BAR), xst);
#undef GRID_SYNC
#define GRID_SYNC() xcd_barrier(xbar)
    for (int half = 0; half < 2; ++half) {
        for (int layer = 0; layer < 2; ++layer) {
            const bf16_t* W1t = (const bf16_t*)(ws + WS_W1T) + (size_t)layer * NG1 * 1024;
            const bf16_t* Wmg = (const bf16_t*)(ws + WS_WMG) + (size_t)layer * 4096 * 1024;
            const bf16_t* Wb = (const bf16_t*)(ws + WS_WB) + (size_t)layer * 1024 * 2048;
            const bf16_t* Wo = (const bf16_t*)(ws + WS_WO) + (size_t)layer * 1024 * 1024;
            const int bid = opaque_s((int)blockIdx.x);
            const float* hsrc = p.in[0] + (size_t)half * TH * 1024;
            float* hdst = p.out + (size_t)half * TH * 1024;
            if (layer == 0 && half == 1) { pre_phase(hsrc, hb, rstd, G); GRID_SYNC(); }
            if (layer == 1) {
                const float* ssq = rstd + TH;
                for (int r = bid * 512 + (int)threadIdx.x; r < TH; r += G * 512) {
                    const f32x4 a = *(const f32x4*)(ssq + (size_t)r * 4), b = *(const f32x4*)(ssq + (size_t)(TH + r) * 4), c = *(const f32x4*)(ssq + (size_t)(2 * TH + r) * 4), d = *(const f32x4*)(ssq + (size_t)(3 * TH + r) * 4);
                    const f32x4 t = (a + b) + (c + d); rstd[r] = rsqrtf(((t[0] + t[1]) + (t[2] + t[3])) * (1.0f / 1024.0f) + NORM_EPS); }
                GRID_SYNC(); }
            { gm::InProjOrder S{(const char*)hb, (const char*)W1t, (const char*)Wmg, (size_t)256 * 1024 * 2, (size_t)256 * 1024 * 2, GATES_EARLY, G, bid};
              gm::EpiInProj E{{proj, NP, rstd}, {gates, 4096, rstd}};
              gm::gemm_phase(lds, S, E, 1024, 1024, 1024); }
            GRID_SYNC();
            { unsigned* ctr = (unsigned*)(ws + WS_CTL) + (layer * 2 + half) * 32;
              for (;;) { const int u = next_unit(ctr, lds); if (u >= 896) break;
                if (u < 128) sg_unit(lds, proj, u * 128, p.in[8] + layer * 512, p.in[9] + layer * 512, p.in[10] + (size_t)layer * 4 * 128 * 128, p.in[11] + layer * 4 * 128);
                else if (u < 384) { const int v = u - 128; const int bl = v >> 6;
                    lru_prep(lds, proj, bl, (v >> 4) & 3, (v & 15) * PREP_NCH, p.in[12] + layer * 4 * 512, p.in[13] + layer * 512, p.in[14] + (size_t)layer * 4 * 128 * 128, p.in[15] + layer * 512,
                             p.in[16] + (size_t)layer * 4 * 128 * 128, p.in[17] + layer * 512, p.in[18] + layer * 512, car + (size_t)bl * 64 * 512 * 2); }
                else if (u < 640) { const int v = u - 384; const int bh = v >> 4, c0 = (v & 15) * PREP_NCH; prep_attn<128, false>(lds, proj, bh >> 2, bh & 3, c0, layer, p.in[3], nullptr, escA + (size_t)(bh * 64 + c0) * 3 * 128); }
                else { const int v = u - 640; const int bh = v >> 4, c0 = (v & 15) * PREP_NCH; prep_attn<64, true>(lds, proj, bh >> 2, bh & 3, c0, layer, nullptr, p.in[6], escB + (size_t)(bh * 64 + c0) * 3 * 64); } } }
            GRID_SYNC();
            if (bid < 32) chain_hg_half(lds, proj, bid >> 3, (bid >> 1) & 3, escA + (size_t)(bid >> 1) * 64 * 3 * 128, (bid & 1) * 64);
            else if (bid < 48) chain_attn<64, true>(lds, proj, (bid - 32) >> 2, (bid - 32) & 3, escB + (size_t)(bid - 32) * 64 * 3 * 64, 0, 8);
            else if (bid < 52) lru_scan(car + (size_t)(bid - 48) * 64 * 512 * 2, hin + (size_t)(bid - 48) * 64 * 512);
            else if (bid >= N_CHAIN_BLOCKS) { gm::StaticOrder S; S.init(hb, Wmg, 1024, 1024, TH, 4096, G - N_CHAIN_BLOCKS, bid - N_CHAIN_BLOCKS, 1024 - GATES_EARLY);
              gm::EpiGateU8 E{gates, 4096, rstd};
              gm::gemm_phase(lds, S, E, 1024, 1024, 1024); }
            GRID_SYNC();
            for (int u = bid; u < 2560; u += G) {
                if (u >= 2304) { sg_post(proj, (u - 2304) * 64); continue; }
                if (u < 1024) { const int bh = u >> 6; post_attn(lds, proj, bh >> 2, bh & 3, u & 63, false, p.in[4] + layer * 128); }
                else if (u < 2048) { const int v = u - 1024; const int bh = v >> 6; post_attn(lds, proj, bh >> 2, bh & 3, v & 63, true, p.in[7] + layer * 128); }
                else { const int v = u - 2048; lru_post(proj, v >> 6, v & 63, hin + (size_t)(v >> 6) * 64 * 512); } }
            GRID_SYNC();
            { gm::BranchOrder S{(const char*)proj, (const char*)Wb, (size_t)256 * NP * 2, (size_t)256 * 2048 * 2, G, bid};
              gm::EpiBranch E{gates, part, proj + C_MERGED, NP};
              gm::gemm_phase(lds, S, E, 512, NP, 2048); }
            GRID_SYNC();
            { gm::StaticOrder S; S.init(proj + C_MERGED, Wo, NP, 1024, TH, 1024, G, bid);
              if (layer == 0) { gm::EpiResidToBf16 E{hsrc, hb, rstd + TH}; gm::gemm_phase(lds, S, E, 1024, NP, 1024); }
              else { gm::EpiResidFromBf16 E{hb, hdst}; gm::gemm_phase(lds, S, E, 1024, NP, 1024); } }
            GRID_SYNC();
        }
    }
    final_phase(p.out, p.in[21], G);
}

extern "C" void kernel_launch(void* const* d_in, const int* in_sizes, int n_in, void* d_out, int out_size, void* d_ws, size_t ws_size, hipStream_t stream) {
    static int grid_blocks = 0;
    if (!grid_blocks) {
        if (n_in != 22 || ws_size < WS_END) { fprintf(stderr, "kernel_launch: need 22 inputs and %zu ws bytes (got %d, %zu)\n", (size_t)WS_END, n_in, ws_size); grid_blocks = -1; return; }
        int dev = 0, cus = 0, per_cu = 0;
        hipGetDevice(&dev);
        hipDeviceGetAttribute(&cus, hipDeviceAttributeMultiprocessorCount, dev);
        if (hipFuncSetAttribute((const void*)mega, hipFuncAttributeMaxDynamicSharedMemorySize, LDS_BYTES) != hipSuccess) { fprintf(stderr, "kernel_launch: hipFuncSetAttribute failed\n"); grid_blocks = -1; return; }
        if (hipOccupancyMaxActiveBlocksPerMultiprocessor(&per_cu, (const void*)mega, 512, LDS_BYTES) != hipSuccess || per_cu < 1) { fprintf(stderr, "kernel_launch: occupancy query gave %d\n", per_cu); grid_blocks = -1; return; }
        grid_blocks = cus * per_cu;
        if (grid_blocks < 64) { fprintf(stderr, "kernel_launch: grid %d too small\n", grid_blocks); grid_blocks = -1; return; }
    }
    if (grid_blocks < 0) return;
    Params p{};
    for (int i = 0; i < 22; ++i) p.in[i] = (const float*)d_in[i];
    p.out = (float*)d_out; p.ws = (unsigned char*)d_ws;
    void* args[] = {&p};
    hipError_t e = hipLaunchCooperativeKernel((const void*)mega, dim3(grid_blocks), dim3(512), args, LDS_BYTES, stream);
    if (e != hipSuccess) fprintf(stderr, "cooperative launch failed: %s (grid %d)\n", hipGetErrorString(e), grid_blocks);
}
```
